# Optimizing an MI355X kernel written in HIP

```python
import math
import jax, jax.numpy as jnp
from jax import lax
import numpy as np

D_MODEL = 2048
BATCH = 1
SEQ = 8192
DEPTH = 1

CHUNK = 64
Q_BLOCK = 128
CONV_WIDTH = D_MODEL // 2
ATTN_WIDTH = D_MODEL - CONV_WIDTH
CONV_KERNEL = 31
N_HEADS = 8
V_HEAD_DIM = ATTN_WIDTH // N_HEADS
QK_HEAD_DIM = V_HEAD_DIM // 2
D_FF = 5632
N_MOD = 9
IN_WIDTH = 2 * CONV_WIDTH + 3 * ATTN_WIDTH
EPS = 1e-6
NEG_INF = -1e30

kernel_name = 'hybrid_conformer_diffattn_macaron_block'


def rms_norm(x, g):
    xf = x.astype(jnp.float32)
    y = xf * lax.rsqrt(jnp.mean(xf * xf, axis=-1, keepdims=True) + EPS)
    return (y * g.astype(jnp.float32)).astype(x.dtype)


def layer_norm(x, g, b):
    xf = x.astype(jnp.float32)
    mu = jnp.mean(xf, axis=-1, keepdims=True)
    xc = xf - mu
    y = xc * lax.rsqrt(jnp.mean(xc * xc, axis=-1, keepdims=True) + EPS)
    return (y * g.astype(jnp.float32) + b.astype(jnp.float32)).astype(x.dtype)


def modulate(h, shift, scale):
    return h * (1 + scale) + shift


def swiglu(h, w_gate, w_up, w_down):
    return (jax.nn.silu(h @ w_gate) * (h @ w_up)) @ w_down


def alibi_slopes():
    return 2.0 ** (-8.0 * (jnp.arange(N_HEADS, dtype=jnp.float32) + 1.0) / N_HEADS)


def lambda_init_fn(layer_idx):
    return 0.8 - 0.6 * math.exp(-0.3 * layer_idx)


def conformer_conv(u, b_in, w_dw, b_dw, ln_g, ln_b):
    u = u + b_in
    a, g = jnp.split(u, 2, axis=-1)
    v = a * jax.nn.sigmoid(g)
    v = lax.conv_general_dilated(
        v, w_dw[:, None, :], window_strides=(1,),
        padding=[(CONV_KERNEL - 1, 0)],
        dimension_numbers=('NWC', 'WIO', 'NWC'),
        feature_group_count=CONV_WIDTH) + b_dw
    return jax.nn.silu(layer_norm(v, ln_g, ln_b))


def diff_attention(q, k, v, lam, subln_g, lam_init):
    B, S = q.shape[0], q.shape[1]
    n_blk = S // Q_BLOCK
    scale = QK_HEAD_DIM ** -0.5
    slopes = alibi_slopes()
    k_pos = jnp.arange(S)
    k_chunk = k_pos // CHUNK
    q_blocks = q.reshape(B, n_blk, Q_BLOCK, N_HEADS, 2, QK_HEAD_DIM).transpose(1, 0, 2, 3, 4, 5)

    def block(args):
        q_blk, i = args
        q_pos = i * Q_BLOCK + jnp.arange(Q_BLOCK)
        s = jnp.einsum('bqhmd,bkhmd->bhmqk', q_blk, k).astype(jnp.float32) * scale
        dist = jnp.abs(q_pos[:, None] - k_pos[None, :]).astype(jnp.float32)
        allowed = k_chunk[None, :] <= (q_pos // CHUNK)[:, None]
        s = jnp.where(allowed, s - slopes[None, :, None, None, None] * dist, NEG_INF)
        p = jax.nn.softmax(s, axis=-1)
        a = p[:, :, 0] - lam * p[:, :, 1]
        return jnp.einsum('bhqk,bkhe->bqhe', a.astype(v.dtype), v)

    o = lax.map(block, (q_blocks, jnp.arange(n_blk)))
    o = o.transpose(1, 0, 2, 3, 4).reshape(B, S, N_HEADS, V_HEAD_DIM)
    o = rms_norm(o, subln_g) * (1.0 - lam_init)
    return o.reshape(B, S, ATTN_WIDTH)


def setup_inputs(seed: int = 0) -> dict:
    key = jax.random.key(seed)
    ks = jax.random.split(key, 26)
    f32 = jnp.float32
    D, L = D_MODEL, DEPTH

    def nrm(k, shape, std):
        return jax.random.normal(k, shape, f32) * std

    return {
        'x': nrm(ks[0], (BATCH, SEQ, D), 1.0),
        'c': nrm(ks[1], (BATCH, D), 1.0),
        'w_ada': nrm(ks[2], (L, D, N_MOD * D), 0.5 * D ** -0.5),
        'b_ada': nrm(ks[3], (L, N_MOD * D), 0.01),
        'g_pre': 1.0 + nrm(ks[4], (L, 3, D), 0.02),
        'g_post': 1.0 + nrm(ks[5], (L, 3, D), 0.02),
        'w_ffn1_gate': nrm(ks[6], (L, D, D_FF), D ** -0.5),
        'w_ffn1_up': nrm(ks[7], (L, D, D_FF), D ** -0.5),
        'w_ffn1_down': nrm(ks[8], (L, D_FF, D), D_FF ** -0.5),
        'w_in': nrm(ks[9], (L, D, IN_WIDTH), D ** -0.5),
        'b_in_conv': nrm(ks[10], (L, 2 * CONV_WIDTH), 0.02),
        'w_dw': nrm(ks[11], (L, CONV_KERNEL, CONV_WIDTH), CONV_KERNEL ** -0.5),
        'b_dw': nrm(ks[12], (L, CONV_WIDTH), 0.02),
        'conv_ln_g': 1.0 + nrm(ks[13], (L, CONV_WIDTH), 0.02),
        'conv_ln_b': nrm(ks[14], (L, CONV_WIDTH), 0.02),
        'lam_q1': nrm(ks[15], (L, QK_HEAD_DIM), 0.1),
        'lam_k1': nrm(ks[16], (L, QK_HEAD_DIM), 0.1),
        'lam_q2': nrm(ks[17], (L, QK_HEAD_DIM), 0.1),
        'lam_k2': nrm(ks[18], (L, QK_HEAD_DIM), 0.1),
        'subln_g': 1.0 + nrm(ks[19], (L, V_HEAD_DIM), 0.02),
        'w_out': nrm(ks[20], (L, CONV_WIDTH + ATTN_WIDTH, D), (CONV_WIDTH + ATTN_WIDTH) ** -0.5),
        'w_ffn2_gate': nrm(ks[21], (L, D, D_FF), D ** -0.5),
        'w_ffn2_up': nrm(ks[22], (L, D, D_FF), D ** -0.5),
        'w_ffn2_down': nrm(ks[23], (L, D_FF, D), D_FF ** -0.5),
    }


def reference(x, c, w_ada, b_ada, g_pre, g_post, w_ffn1_gate, w_ffn1_up, w_ffn1_down,
              w_in, b_in_conv, w_dw, b_dw, conv_ln_g, conv_ln_b,
              lam_q1, lam_k1, lam_q2, lam_k2, subln_g, w_out,
              w_ffn2_gate, w_ffn2_up, w_ffn2_down):
    B, S = x.shape[0], x.shape[1]
    split_pts = [2 * CONV_WIDTH, 2 * CONV_WIDTH + ATTN_WIDTH, 2 * CONV_WIDTH + 2 * ATTN_WIDTH]
    for l in range(DEPTH):
        lam_init = lambda_init_fn(l)
        mod = (jax.nn.silu(c) @ w_ada[l] + b_ada[l])[:, None, :]
        sh1, sc1, gt1, sh2, sc2, gt2, sh3, sc3, gt3 = jnp.split(mod, N_MOD, axis=-1)

        h = modulate(rms_norm(x, g_pre[l, 0]), sh1, sc1)
        x = x + 0.5 * gt1 * rms_norm(swiglu(h, w_ffn1_gate[l], w_ffn1_up[l], w_ffn1_down[l]), g_post[l, 0])

        h = modulate(rms_norm(x, g_pre[l, 1]), sh2, sc2)
        proj = h @ w_in[l]
        u_conv, q, k, v = jnp.split(proj, split_pts, axis=-1)
        y_conv = conformer_conv(u_conv, b_in_conv[l], w_dw[l], b_dw[l], conv_ln_g[l], conv_ln_b[l])
        q = q.reshape(B, S, N_HEADS, 2, QK_HEAD_DIM)
        k = k.reshape(B, S, N_HEADS, 2, QK_HEAD_DIM)
        v = v.reshape(B, S, N_HEADS, V_HEAD_DIM)
        lam = (jnp.exp(jnp.sum(lam_q1[l].astype(jnp.float32) * lam_k1[l].astype(jnp.float32)))
               - jnp.exp(jnp.sum(lam_q2[l].astype(jnp.float32) * lam_k2[l].astype(jnp.float32)))
               + lam_init)
        y_attn = diff_attention(q, k, v, lam, subln_g[l], lam_init)
        y_mix = jnp.concatenate([y_conv, y_attn], axis=-1) @ w_out[l]
        x = x + gt2 * rms_norm(y_mix, g_post[l, 1])

        h = modulate(rms_norm(x, g_pre[l, 2]), sh3, sc3)
        x = x + 0.5 * gt3 * rms_norm(swiglu(h, w_ffn2_gate[l], w_ffn2_up[l], w_ffn2_down[l]), g_post[l, 2])
    return x
```

```cpp
#include <hip/hip_runtime.h>
#include <hip/hip_cooperative_groups.h>
#include <cstdio>
#include <cstdint>
namespace cg = cooperative_groups;
namespace pg8 {
#define PG8_LAS __attribute__((address_space(3)))
typedef unsigned short bf16_t;
typedef short bf16x8 __attribute__((ext_vector_type(8)));
typedef float f32x4 __attribute__((ext_vector_type(4)));
typedef unsigned u32x4 __attribute__((ext_vector_type(4)));
constexpr int BM = 256, BK = 64, HALF = 128, HTB = HALF * BK * 2  , STAGE_BYTES = 8 * HTB, NXCD = 8, WGM = 4;

__host__ __device__ __forceinline__ int lds_byte(int r, int c) { const int st = (r >> 4) * 2 + (c >> 5), rr = r & 15, cc = c & 31, ob = rr * 64 + cc * 2; return st * 1024 + (ob ^ (((ob >> 9) & 1) << 5)); }
__host__ __device__ __forceinline__ void stage_rc(int b, int& R, int& C) { const int st = b / 1024, sb = b % 1024, swz = sb ^ (((sb >> 9) & 1) << 5); R = (st >> 1) * 16 + swz / 64; C = (st & 1) * 32 + (swz % 64) / 2; }
__host__ __device__ __forceinline__ int perm32(int rho) { const int n = rho >> 4, i = rho & 15; return 8 * (i >> 2) + 4 * n + (i & 3); }

struct Unit { int pm, pn; };
struct Gemm { const bf16_t* A; const bf16_t* Bt; int M, N, K; };

struct StaticOrder {
    int nM, nN, nwg, G, c;
    __host__ __device__ void init(int M, int N, int G_, int c_) { nM = M / BM; nN = N / BM; nwg = nM * nN; G = G_; c = c_; }
    __host__ __device__ bool next(int i, Unit& u) const {
        const long L = (long)i * G + c; if (L >= nwg) return false;
        int wgid = (int)L; { const int q = nwg / NXCD, r = nwg % NXCD, xcd = wgid % NXCD, off = wgid / NXCD; wgid = (xcd < r ? xcd * (q + 1) : r * (q + 1) + (xcd - r) * q) + off; }
        const int nig = WGM * nN, gid = wgid / nig, fm = gid * WGM, gsz = (nM - fm) < WGM ? (nM - fm) : WGM;
        u.pm = fm + ((wgid % nig) % gsz); u.pn = (wgid % nig) / gsz; return true;
    }
    __device__ __forceinline__ void a_ready(const Unit&) const {}
    __device__ __forceinline__ void done(const Unit&) const {}
};

__device__ __forceinline__ unsigned cvt_pk_bf16(float lo, float hi) { unsigned r; asm volatile("v_cvt_pk_bf16_f32 %0, %1, %2" : "=v"(r) : "v"(lo), "v"(hi)); return r; }
typedef float f32x2 __attribute__((ext_vector_type(2)));
template <class Epi, class Sched, bool ALIGN_EPI = false, bool SP2 = false>
__device__ __forceinline__ void gemm_phase(PG8_LAS unsigned char* lds, const Gemm g, const Sched& S, const Epi& E) {
    const int tid = threadIdx.x, wid = __builtin_amdgcn_readfirstlane(tid >> 6), lane = tid & 63, wr = wid >> 2, wc = wid & 3, fr = lane & 15, fq = lane >> 4;
    const int K = g.K, nt = K / BK;
    unsigned voffA[2], voffB[2];
#pragma unroll
    for (int i = 0; i < 2; ++i) { int R, C; stage_rc(tid * 16 + i * 8192, R, C); const int Rb = Epi::PERM ? ((R & ~31) + perm32(R & 31)) : R;
        voffA[i] = (unsigned)(R * K + C) * 2u; voffB[i] = (unsigned)(Rb * K + C) * 2u; }
    const size_t kstep = (size_t)(BK * 2);
    const size_t hstep = (size_t)HALF * K * 2;
    const size_t tstep = 2 * hstep;
    const unsigned ldsw = (unsigned)wid * 1024u;
    const int aoff = lds_byte(wr * 64 + fr, fq * 8), boff = lds_byte(wc * 32 + fr, fq * 8);
#define PG8_SA(b, h) (((b) * 2 + (h)) * HTB)
#define PG8_SB(b, h) ((4 + (b) * 2 + (h)) * HTB)
#define PG8_STAGE(bufoff, gbase, voff) do { _Pragma("unroll") for (int _i = 0; _i < 2; ++_i) \
        __builtin_amdgcn_global_load_lds((const unsigned*)((const char*)(gbase) + (voff)[_i]), (PG8_LAS unsigned*)(lds + (bufoff) + ldsw + _i * 8192), 16, 0, 0); } while (0)
#define PG8_LDA(dst, b, h) do { _Pragma("unroll") for (int m = 0; m < 4; ++m) _Pragma("unroll") for (int k = 0; k < 2; ++k) dst[m][k] = *(const PG8_LAS bf16x8*)(lds + PG8_SA(b, h) + aoff + m * 2048 + k * 1024); } while (0)
#define PG8_LDB(dst, b, h) do { _Pragma("unroll") for (int n = 0; n < 2; ++n) _Pragma("unroll") for (int k = 0; k < 2; ++k) dst[n][k] = *(const PG8_LAS bf16x8*)(lds + PG8_SB(b, h) + boff + n * 2048 + k * 1024); } while (0)
#define PG8_MMA(ai, bj, At, Bt) do { __builtin_amdgcn_s_setprio(1); _Pragma("unroll") for (int m = 0; m < 4; ++m) _Pragma("unroll") for (int n = 0; n < 2; ++n) _Pragma("unroll") for (int k = 0; k < 2; ++k) \
        acc[ai][bj][m][n] = __builtin_amdgcn_mfma_f32_16x16x32_bf16(Bt[n][k], At[m][k], acc[ai][bj][m][n], 0, 0, 0); __builtin_amdgcn_s_setprio(0); } while (0)
#define PG8_WAIT_V(n) asm volatile("s_waitcnt vmcnt(" #n ")" ::: "memory")
#define PG8_WAIT_L(n) asm volatile("s_waitcnt lgkmcnt(" #n ")" ::: "memory")
#define PG8_BAR __builtin_amdgcn_s_barrier()
#define PG8_SCHED __builtin_amdgcn_sched_barrier(0)
    Unit cur, nxt; int ui = 0;
    if (!S.next(0, cur)) return;
    f32x4 acc[2][2][4][2];
#pragma unroll
    for (int a = 0; a < 2; ++a)
#pragma unroll
        for (int b = 0; b < 2; ++b)
#pragma unroll
            for (int m = 0; m < 4; ++m)
#pragma unroll
                for (int n = 0; n < 2; ++n) acc[a][b][m][n] = (f32x4){0.f, 0.f, 0.f, 0.f};
    bf16x8 At[4][2], B0[2][2], B1[2][2];
    const char* cA = (const char*)g.A + (size_t)cur.pm * tstep; const char* cB = (const char*)g.Bt + (size_t)cur.pn * tstep;
    S.a_ready(cur);
    if constexpr (SP2) {
        PG8_STAGE(PG8_SB(0, 0), cB, voffB); PG8_STAGE(PG8_SB(0, 1), cB + hstep, voffB); PG8_STAGE(PG8_SA(0, 0), cA, voffA); PG8_STAGE(PG8_SA(0, 1), cA + hstep, voffA);
        if (wr == 1) PG8_BAR;
        PG8_WAIT_V(2); PG8_BAR;
        PG8_STAGE(PG8_SB(1, 0), cB + kstep, voffB); PG8_STAGE(PG8_SA(1, 0), cA + kstep, voffA); PG8_STAGE(PG8_SB(1, 1), cB + hstep + kstep, voffB);
        PG8_WAIT_V(6); PG8_BAR;
    } else {
        PG8_STAGE(PG8_SB(0, 0), cB, voffB); PG8_STAGE(PG8_SA(0, 0), cA, voffA); PG8_STAGE(PG8_SB(0, 1), cB + hstep, voffB); PG8_STAGE(PG8_SA(0, 1), cA + hstep, voffA);
        if (wr == 1) PG8_BAR;
        PG8_WAIT_V(4); PG8_BAR;
        PG8_STAGE(PG8_SB(1, 0), cB + kstep, voffB); PG8_STAGE(PG8_SA(1, 0), cA + kstep, voffA); PG8_STAGE(PG8_SB(1, 1), cB + hstep + kstep, voffB);
        PG8_WAIT_V(6); PG8_BAR;
    }
    for (;;) {
        const bool has_next = S.next(ui + 1, nxt);
        const char* nA = has_next ? (const char*)g.A + (size_t)nxt.pm * tstep : cA; const char* nB = has_next ? (const char*)g.Bt + (size_t)nxt.pn * tstep : cB;
        for (int t = 0; t < nt; t += 2) {
            const bool last = (t == nt - 2);
            const char* a1 = cA + (size_t)(t + 1) * kstep;
            const char* a2 = last ? nA : cA + (size_t)(t + 2) * kstep; const char* b2 = last ? nB : cB + (size_t)(t + 2) * kstep;
            const char* a3 = a2 + kstep; const char* b3 = b2 + kstep;
            if (last && has_next) S.a_ready(nxt);
            if constexpr (SP2) {
            PG8_LDB(B0, 0, 0); PG8_LDB(B1, 0, 1); PG8_SCHED; PG8_LDA(At, 0, 0); PG8_STAGE(PG8_SA(1, 1), a1 + hstep, voffA);
            PG8_WAIT_V(8); PG8_WAIT_L(0); PG8_BAR; PG8_MMA(0, 0, At, B0); PG8_MMA(0, 1, At, B1); PG8_BAR; PG8_SCHED;
            PG8_LDA(At, 0, 1); PG8_STAGE(PG8_SB(0, 0), b2, voffB); PG8_STAGE(PG8_SB(0, 1), b2 + hstep, voffB); PG8_STAGE(PG8_SA(0, 0), a2, voffA);
            PG8_WAIT_V(8); PG8_WAIT_L(0); PG8_BAR; PG8_MMA(1, 0, At, B0); PG8_MMA(1, 1, At, B1); PG8_BAR; PG8_SCHED;
            PG8_LDB(B0, 1, 0); PG8_LDB(B1, 1, 1); PG8_SCHED; PG8_LDA(At, 1, 0); PG8_STAGE(PG8_SA(0, 1), a2 + hstep, voffA);
            PG8_WAIT_V(8); PG8_WAIT_L(0); PG8_BAR; PG8_MMA(0, 0, At, B0); PG8_MMA(0, 1, At, B1); PG8_BAR; PG8_SCHED;
            PG8_LDA(At, 1, 1); PG8_STAGE(PG8_SB(1, 0), b3, voffB); PG8_STAGE(PG8_SB(1, 1), b3 + hstep, voffB); PG8_STAGE(PG8_SA(1, 0), a3, voffA);
            PG8_WAIT_V(8); PG8_WAIT_L(0); PG8_BAR; PG8_MMA(1, 0, At, B0); PG8_MMA(1, 1, At, B1); PG8_BAR; PG8_SCHED;
            } else {
            PG8_LDB(B0, 0, 0); PG8_SCHED; PG8_LDA(At, 0, 0); PG8_STAGE(PG8_SA(1, 1), a1 + hstep, voffA);
            PG8_WAIT_L(8); PG8_BAR; PG8_WAIT_L(0); PG8_MMA(0, 0, At, B0); PG8_BAR; PG8_SCHED;
            PG8_LDB(B1, 0, 1); PG8_STAGE(PG8_SB(0, 0), b2, voffB);
            PG8_BAR; PG8_WAIT_L(0); PG8_MMA(0, 1, At, B1); PG8_BAR;
            PG8_LDA(At, 0, 1); PG8_STAGE(PG8_SA(0, 0), a2, voffA);
            PG8_BAR; PG8_WAIT_L(0); PG8_MMA(1, 0, At, B0); PG8_BAR; PG8_SCHED;
            PG8_STAGE(PG8_SB(0, 1), b2 + hstep, voffB);
            PG8_WAIT_V(6); PG8_BAR; PG8_MMA(1, 1, At, B1); PG8_BAR;
            PG8_LDB(B0, 1, 0); PG8_SCHED; PG8_LDA(At, 1, 0); PG8_STAGE(PG8_SA(0, 1), a2 + hstep, voffA);
            PG8_WAIT_L(8); PG8_BAR; PG8_WAIT_L(0); PG8_MMA(0, 0, At, B0); PG8_BAR; PG8_SCHED;
            PG8_LDB(B1, 1, 1); PG8_STAGE(PG8_SB(1, 0), b3, voffB);
            PG8_BAR; PG8_WAIT_L(0); PG8_MMA(0, 1, At, B1); PG8_BAR;
            PG8_LDA(At, 1, 1); PG8_STAGE(PG8_SA(1, 0), a3, voffA);
            PG8_BAR; PG8_WAIT_L(0); PG8_MMA(1, 0, At, B0); PG8_BAR; PG8_SCHED;
            PG8_STAGE(PG8_SB(1, 1), b3 + hstep, voffB);
            PG8_WAIT_V(6); PG8_BAR; PG8_MMA(1, 1, At, B1); PG8_BAR;
            }
        }
        if constexpr (ALIGN_EPI) { if (wr == 0) PG8_BAR; }
        if constexpr (!Epi::AFTER_DRAIN) { E(acc, cur, wr, wc, fr, fq); S.done(cur); }
        if (!has_next) break;
#pragma unroll
        for (int a = 0; a < 2; ++a)
#pragma unroll
            for (int b = 0; b < 2; ++b)
#pragma unroll
                for (int m = 0; m < 4; ++m)
#pragma unroll
                    for (int n = 0; n < 2; ++n) acc[a][b][m][n] = (f32x4){0.f, 0.f, 0.f, 0.f};
        cur = nxt; cA = nA; cB = nB; ++ui;
        if constexpr (ALIGN_EPI) { if (wr == 1) PG8_BAR; }
    }
    PG8_WAIT_V(0);
    if constexpr (!ALIGN_EPI) { if (wr == 0) PG8_BAR; }
    PG8_BAR;
    if constexpr (Epi::AFTER_DRAIN) { E.fused(acc, cur, wr, wc, fr, fq, lds, wid, lane); S.done(cur); }
#undef PG8_SA
#undef PG8_SB
#undef PG8_STAGE
#undef PG8_LDA
#undef PG8_LDB
#undef PG8_MMA
#undef PG8_WAIT_V
#undef PG8_WAIT_L
#undef PG8_BAR
#undef PG8_SCHED
}
}

#ifndef PG8_SP2
#define PG8_SP2 true
#endif
#ifndef PG8_ALIGN
#define PG8_ALIGN true
#endif
#ifndef MK_SPLIT
#define MK_SPLIT 0
#endif

constexpr int SEQ = 8192, DM = 2048, DFF = 5632, CW = 1024, AW = 1024, NH = 8, INW = 5120, NMOD = 9, CK = 31;
constexpr int NMODW = NMOD * DM;
constexpr int KSPLIT = 16;
constexpr float EPS = 1e-6f;
constexpr float LOG2E = 1.4426950408889634f;
constexpr float QSCALE = 0.125f * LOG2E;
constexpr int NPHASE = 12;

constexpr size_t MiB = 1u << 20;
constexpr size_t WS_MODP = 1 * MiB;
constexpr size_t WS_WGU1 = 4 * MiB, WS_WD1 = 48 * MiB, WS_WIN = 70 * MiB, WS_WOUT = 90 * MiB, WS_WGU2 = 98 * MiB, WS_WD2 = 142 * MiB;
constexpr size_t WS_H = 164 * MiB, WS_ACT = 196 * MiB;
constexpr size_t WS_VG = WS_ACT, WS_Q = WS_ACT + 16 * MiB, WS_K = WS_ACT + 32 * MiB, WS_VT = WS_ACT + 48 * MiB, WS_YCAT = WS_ACT + 64 * MiB;
constexpr size_t WS_Y = 292 * MiB, WS_X1 = 356 * MiB, WS_PART = 420 * MiB, WS_END = 440 * MiB;
constexpr int PART_FLOATS = 32768 + 1024;

constexpr int LDS_BYTES = 147456;

#define LAS __attribute__((address_space(3)))
typedef unsigned short bf16_t;
typedef float f32x4 __attribute__((ext_vector_type(4)));
typedef float f32x16 __attribute__((ext_vector_type(16)));
typedef unsigned u32x4 __attribute__((ext_vector_type(4)));
typedef unsigned u32x2 __attribute__((ext_vector_type(2)));
typedef short bf16x8 __attribute__((ext_vector_type(8)));

__device__ __forceinline__ unsigned f2bf(float f) { unsigned u = __builtin_bit_cast(unsigned, f); return (u + 0x7fffu + ((u >> 16) & 1u)) >> 16; }
__device__ __forceinline__ unsigned pk2(float lo, float hi) { return pg8::cvt_pk_bf16(lo, hi); }
__device__ __forceinline__ float bflo(unsigned u) { return __builtin_bit_cast(float, u << 16); }
__device__ __forceinline__ float bfhi(unsigned u) { return __builtin_bit_cast(float, u & 0xffff0000u); }
__device__ __forceinline__ float sigm(float x) { return __builtin_amdgcn_rcpf(1.f + __builtin_amdgcn_exp2f(-LOG2E * x)); }
__device__ __forceinline__ float wave_sum(float v) {
#pragma unroll
    for (int o = 1; o < 64; o <<= 1) v += __shfl_xor(v, o);
    return v;
}

struct EpiSwiGLU {
    static constexpr bool PERM = true, AFTER_DRAIN = false;
    bf16_t* O; int ldo;
    __device__ __forceinline__ void operator()(const pg8::f32x4 (&acc)[2][2][4][2], const pg8::Unit& u, int wr, int wc, int fr, int fq) const {
        const int row0 = u.pm * 256 + wr * 64 + fr, col0 = u.pn * 128 + wc * 32 + 8 * fq;
#pragma unroll
        for (int ai = 0; ai < 2; ++ai)
#pragma unroll
            for (int m = 0; m < 4; ++m) {
                bf16_t* rowp = O + (size_t)(row0 + ai * 128 + m * 16) * ldo + col0;
                float v[8];
#pragma unroll
                for (int n = 0; n < 2; ++n)
#pragma unroll
                    for (int i = 0; i < 4; ++i) { const float g = acc[ai][0][m][n][i], up = acc[ai][1][m][n][i]; v[n * 4 + i] = g * sigm(g) * up; }
                u32x4 w; w.x = pk2(v[0], v[1]); w.y = pk2(v[2], v[3]); w.z = pk2(v[4], v[5]); w.w = pk2(v[6], v[7]);
                *(u32x4*)rowp = w;
            }
    }
};
struct EpiInProj {
    static constexpr bool PERM = true, AFTER_DRAIN = false;
    bf16_t* VG; bf16_t* Q; bf16_t* K; const float* b_in; unsigned* kmax2c;
    __device__ __forceinline__ void operator()(const pg8::f32x4 (&acc)[2][2][4][2], const pg8::Unit& u, int wr, int wc, int fr, int fq) const {
        const int row0 = u.pm * 256 + wr * 64 + fr;
        if (u.pn < 8) {
            const int col0 = u.pn * 128 + wc * 32 + 8 * fq;
            f32x4 ba[2], bg[2];
#pragma unroll
            for (int n = 0; n < 2; ++n) { ba[n] = *(const f32x4*)(b_in + col0 + 4 * n); bg[n] = *(const f32x4*)(b_in + CW + col0 + 4 * n); }
#pragma unroll
            for (int ai = 0; ai < 2; ++ai)
#pragma unroll
                for (int m = 0; m < 4; ++m) {
                    bf16_t* rowp = VG + (size_t)(row0 + ai * 128 + m * 16) * CW + col0;
                    float v[8];
#pragma unroll
                    for (int n = 0; n < 2; ++n)
#pragma unroll
                        for (int i = 0; i < 4; ++i) { const float a = acc[ai][0][m][n][i] + ba[n][i], g = acc[ai][1][m][n][i] + bg[n][i]; v[n * 4 + i] = a * sigm(g); }
                    u32x4 w; w.x = pk2(v[0], v[1]); w.y = pk2(v[2], v[3]); w.z = pk2(v[4], v[5]); w.w = pk2(v[6], v[7]);
                    *(u32x4*)rowp = w;
                }
        } else {
            const int t = (u.pn - 8) >> 2; bf16_t* base = t ? K : Q; const float sc = t ? 1.f : QSCALE;
            const int col0 = ((u.pn - 8) & 3) * 256 + wc * 32 + 8 * fq;
            float cm[2] = {0.f, 0.f};
#pragma unroll
            for (int ai = 0; ai < 2; ++ai)
#pragma unroll
                for (int m = 0; m < 4; ++m) {
                    bf16_t* rowp = base + (size_t)(row0 + ai * 128 + m * 16) * AW + col0;
#pragma unroll
                    for (int bj = 0; bj < 2; ++bj) {
                        const pg8::f32x4 v0 = acc[ai][bj][m][0] * sc, v1 = acc[ai][bj][m][1] * sc;
                        u32x4 w; w.x = pk2(v0[0], v0[1]); w.y = pk2(v0[2], v0[3]); w.z = pk2(v1[0], v1[1]); w.w = pk2(v1[2], v1[3]);
                        *(u32x4*)(rowp + bj * 128) = w;
                        if (t) { const float a0 = bflo(w.x), a1 = bfhi(w.x), a2 = bflo(w.y), a3 = bfhi(w.y), a4 = bflo(w.z), a5 = bfhi(w.z), a6 = bflo(w.w), a7 = bfhi(w.w);
                            cm[bj] = __builtin_fmaxf(cm[bj], ((a0 * a0 + a1 * a1) + (a2 * a2 + a3 * a3)) + ((a4 * a4 + a5 * a5) + (a6 * a6 + a7 * a7))); }
                    }
                }
            if (t) {
#pragma unroll
                for (int bj = 0; bj < 2; ++bj) { float v = cm[bj];
#pragma unroll
                    for (int x = 1; x < 16; x <<= 1) v = __builtin_fmaxf(v, __shfl_xor(v, x));
                    const int col = col0 + bj * 128;
                    if (fr == 0) atomicMax(kmax2c + (col >> 6) * 8 + ((col & 63) >> 3), __builtin_bit_cast(unsigned, v)); }
            }
        }
    }
};
struct EpiBf16Plain {
    static constexpr bool PERM = true, AFTER_DRAIN = false;
    bf16_t* O; int ldo;
    __device__ __forceinline__ void operator()(const pg8::f32x4 (&acc)[2][2][4][2], const pg8::Unit& u, int wr, int wc, int fr, int fq) const {
        const int row0 = u.pm * 256 + wr * 64 + fr, col0 = u.pn * 256 + wc * 32 + 8 * fq;
#pragma unroll
        for (int ai = 0; ai < 2; ++ai)
#pragma unroll
            for (int m = 0; m < 4; ++m) {
                bf16_t* rowp = O + (size_t)(row0 + ai * 128 + m * 16) * ldo + col0;
#pragma unroll
                for (int bj = 0; bj < 2; ++bj) {
                    const pg8::f32x4 v0 = acc[ai][bj][m][0], v1 = acc[ai][bj][m][1];
                    u32x4 w; w.x = pk2(v0[0], v0[1]); w.y = pk2(v0[2], v0[3]); w.z = pk2(v1[0], v1[1]); w.w = pk2(v1[2], v1[3]);
                    *(u32x4*)(rowp + bj * 128) = w;
                }
            }
    }
};
struct EpiF32 {
    static constexpr bool PERM = true, AFTER_DRAIN = false;
    float* O; int ldo;
    __device__ __forceinline__ void operator()(const pg8::f32x4 (&acc)[2][2][4][2], const pg8::Unit& u, int wr, int wc, int fr, int fq) const {
        const int row0 = u.pm * 256 + wr * 64 + fr, col0 = u.pn * 256 + wc * 32 + 8 * fq;
#pragma unroll
        for (int ai = 0; ai < 2; ++ai)
#pragma unroll
            for (int m = 0; m < 4; ++m) {
                float* rowp = O + (size_t)(row0 + ai * 128 + m * 16) * ldo + col0;
#pragma unroll
                for (int bj = 0; bj < 2; ++bj) { *(pg8::f32x4*)(rowp + bj * 128) = acc[ai][bj][m][0]; *(pg8::f32x4*)(rowp + bj * 128 + 4) = acc[ai][bj][m][1]; }
            }
    }
};

struct TrItem { const float* src; bf16_t* dst; int ld, K; };
__device__ __forceinline__ void tr_load(const TrItem& t, float (&v)[32], int lane) {
    const float* wp = t.src + (size_t)(lane >> 5) * t.ld + (lane & 31);
#pragma unroll
    for (int i = 0; i < 32; ++i) v[i] = __builtin_nontemporal_load(wp + (size_t)(2 * i) * t.ld);
}
__device__ __forceinline__ void tr_finish(const TrItem& t, const float (&v)[32], LAS float* scr, int lane) {
#pragma unroll
    for (int i = 0; i < 32; ++i) scr[(2 * i + (lane >> 5)) * 33 + (lane & 31)] = v[i];
    asm volatile("s_waitcnt lgkmcnt(0)" ::: "memory");
    const int c = lane & 7;
#pragma unroll
    for (int j = 0; j < 4; ++j) { const int n = (lane >> 3) + 8 * j; const LAS float* s = scr + (8 * c) * 33 + n;
        u32x4 o; o.x = pk2(s[0 * 33], s[1 * 33]); o.y = pk2(s[2 * 33], s[3 * 33]); o.z = pk2(s[4 * 33], s[5 * 33]); o.w = pk2(s[6 * 33], s[7 * 33]);
        *(u32x4*)(t.dst + (size_t)n * t.K + 8 * c) = o; }
    asm volatile("s_waitcnt lgkmcnt(0)" ::: "memory");
}
__device__ __forceinline__ TrItem mk_item(const float* W, int ld, int srccol0, int k0, bf16_t* WT, int K, int destrow0) {
    TrItem t; t.src = W + (size_t)k0 * ld + srccol0; t.dst = WT + (size_t)destrow0 * K + k0; t.ld = ld; t.K = K; return t;
}
__device__ __forceinline__ TrItem it_gu(const float* wg, const float* wu, bf16_t* WT, int r) {
    constexpr int nblk = 2 * DFF / 32; const int kb = r / nblk, nb = r % nblk, R0 = 32 * nb, pn = R0 >> 8, bj = (R0 >> 7) & 1, j0 = R0 & 127;
    return mk_item(bj ? wu : wg, DFF, 128 * pn + j0, 64 * kb, WT, DM, R0);
}
__device__ __forceinline__ TrItem it_plain(const float* w, int K, int N, bf16_t* WT, int r) {
    const int nblk = N / 32, kb = r / nblk, nb = r % nblk;
    return mk_item(w, N, 32 * nb, 64 * kb, WT, K, 32 * nb);
}
__device__ __forceinline__ TrItem it_in(const float* w, bf16_t* WT, int r) {
    constexpr int nblk = INW / 32; const int kb = r / nblk, nb = r % nblk, R0 = 32 * nb;
    int src = R0;
    if (R0 < 2 * CW) { const int pn = R0 >> 8, bj = (R0 >> 7) & 1, j0 = R0 & 127; src = bj * CW + 128 * pn + j0; }
    return mk_item(w, INW, src, 64 * kb, WT, DM, R0);
}
constexpr int I_GU = (DM / 64) * (2 * DFF / 32), I_D = (DFF / 64) * (DM / 32), I_IN = (DM / 64) * (INW / 32), I_O = (DM / 64) * (DM / 32);
constexpr int NITEMS_A = 2 * I_GU + I_D + I_IN, NITEMS_B = I_O + I_D;
struct WPtrs { const float *w1g, *w1u, *w1d, *win, *wout, *w2g, *w2u, *w2d; bf16_t *Wgu1, *Wd1, *Win, *Wout, *Wgu2, *Wd2; };
__device__ __forceinline__ TrItem item_a(const WPtrs& P, int r) {
    if (r < I_GU) return it_gu(P.w1g, P.w1u, P.Wgu1, r); r -= I_GU;
    if (r < I_D) return it_plain(P.w1d, DFF, DM, P.Wd1, r); r -= I_D;
    if (r < I_IN) return it_in(P.win, P.Win, r); r -= I_IN;
    return it_gu(P.w2g, P.w2u, P.Wgu2, r);
}
__device__ __forceinline__ TrItem item_b(const WPtrs& P, int r) {
    if (r < I_O) return it_plain(P.wout, DM, DM, P.Wout, r);
    return it_plain(P.w2d, DFF, DM, P.Wd2, r - I_O);
}
template <bool LIST_B> __device__ __forceinline__ void tr_run(const WPtrs& P, int first, int stride, LAS float* scr, int lane, int lo = 0, int hi = (LIST_B ? NITEMS_B : NITEMS_A)) {
    if (lo + first >= hi) return;
    float va[32];
    for (int it = lo + first; it < hi; it += stride) { const TrItem ta = LIST_B ? item_b(P, it) : item_a(P, it); tr_load(ta, va, lane); tr_finish(ta, va, scr, lane); }
}

__device__ __forceinline__ f32x4 mod4(const float* modp, const float* b_ada, int idx) {
    f32x4 a = *(const f32x4*)(b_ada + idx);
#pragma unroll
    for (int s = 0; s < KSPLIT; ++s) a += *(const f32x4*)(modp + (size_t)s * NMODW + idx);
    return a;
}

template <bool HAS_Y, bool HAS_H, bool FULLMOD, bool RES_BF16 = false, bool OUT_BF16 = false>
__device__ __forceinline__ void row_phase(LAS unsigned char* lds, int gw, int NGW, int tid, int lane,
                                          const bf16_t* Y, const float* resid, float* xout, bf16_t* H,
                                          const float* modp, const float* b_ada, const float* g_post, int gate_idx, float coef,
                                          const float* g_pre, int sh_idx, int sc_idx) {
    LAS f32x4* G1 = (LAS f32x4*)lds; LAS f32x4* G2 = (LAS f32x4*)(lds + 8192); LAS f32x4* SH = (LAS f32x4*)(lds + 16384);
    {
        const int c = tid * 4;
        if (HAS_Y) { const f32x4 gt = FULLMOD ? *(const f32x4*)(modp + gate_idx * DM + c) : mod4(modp, b_ada, gate_idx * DM + c); G1[tid] = gt * *(const f32x4*)(g_post + c) * coef; }
        if (HAS_H) { const f32x4 sc = FULLMOD ? *(const f32x4*)(modp + sc_idx * DM + c) : mod4(modp, b_ada, sc_idx * DM + c);
                     G2[tid] = *(const f32x4*)(g_pre + c) * (sc + 1.f); SH[tid] = FULLMOD ? *(const f32x4*)(modp + sh_idx * DM + c) : mod4(modp, b_ada, sh_idx * DM + c); }
    }
    __syncthreads();
    for (int row = gw; row < SEQ; row += NGW) {
        f32x4 xv[8];
        const f32x4* rp = (const f32x4*)(resid + (size_t)row * DM) + lane;
        if (HAS_Y) {
            const u32x2* yp = (const u32x2*)(Y + (size_t)row * DM) + lane;
            f32x4 yv[8]; float ss = 0.f; u32x2 yr[8];
#pragma unroll
            for (int j = 0; j < 8; ++j) { yr[j] = __builtin_nontemporal_load(yp + 64 * j);
                if (RES_BF16) { const u32x2 t = __builtin_nontemporal_load((const u32x2*)((const bf16_t*)resid + (size_t)row * DM) + lane + 64 * j); xv[j] = (f32x4){bflo(t.x), bfhi(t.x), bflo(t.y), bfhi(t.y)}; }
                else xv[j] = __builtin_nontemporal_load(rp + 64 * j); }
#pragma unroll
            for (int j = 0; j < 8; ++j) yv[j] = (f32x4){bflo(yr[j].x), bfhi(yr[j].x), bflo(yr[j].y), bfhi(yr[j].y)};
#pragma unroll
            for (int j = 0; j < 8; ++j) ss += (yv[j].x * yv[j].x + yv[j].y * yv[j].y) + (yv[j].z * yv[j].z + yv[j].w * yv[j].w);
            const float r = __builtin_amdgcn_rsqf(wave_sum(ss) * (1.f / DM) + EPS);
            f32x4* op = (f32x4*)(xout + (size_t)row * DM) + lane;
#pragma unroll
            for (int j = 0; j < 8; ++j) { xv[j] = xv[j] + G1[lane + 64 * j] * (yv[j] * r);
                if (OUT_BF16) { u32x2 w; w.x = pk2(xv[j].x, xv[j].y); w.y = pk2(xv[j].z, xv[j].w); ((u32x2*)((bf16_t*)xout + (size_t)row * DM) + lane)[64 * j] = w; }
                else if (HAS_H) op[64 * j] = xv[j]; else __builtin_nontemporal_store(xv[j], op + 64 * j); }
        } else {
#pragma unroll
            for (int j = 0; j < 8; ++j) xv[j] = __builtin_nontemporal_load(rp + 64 * j);
        }
        if (HAS_H) {
            float ss = 0.f;
#pragma unroll
            for (int j = 0; j < 8; ++j) ss += (xv[j].x * xv[j].x + xv[j].y * xv[j].y) + (xv[j].z * xv[j].z + xv[j].w * xv[j].w);
            const float r = __builtin_amdgcn_rsqf(wave_sum(ss) * (1.f / DM) + EPS);
            u32x2* hp = (u32x2*)(H + (size_t)row * DM) + lane;
#pragma unroll
            for (int j = 0; j < 8; ++j) { const f32x4 hv = (xv[j] * r) * G2[lane + 64 * j] + SH[lane + 64 * j]; u32x2 w; w.x = pk2(hv.x, hv.y); w.y = pk2(hv.z, hv.w); hp[64 * j] = w; }
        }
    }
    __syncthreads();
}

__device__ __forceinline__ void conv_unit(LAS unsigned char* lds, int s0, const bf16_t* VG, const float* w_dw, const float* b_dw, const float* ln_g, const float* ln_b,
                                          bf16_t* YC, int tid, int wid, int lane) {
    for (int p = tid; p < 62 * 128; p += 512) { const int i = p >> 7, c = p & 127, srow = s0 - 30 + i;
        u32x4 v = (u32x4){0u, 0u, 0u, 0u}; if (srow >= 0) v = *(const u32x4*)(VG + (size_t)srow * CW + c * 8);
        *(LAS u32x4*)(lds + i * 2048 + c * 16) = v; }
    __syncthreads();
    float acc[4][16];
#pragma unroll
    for (int r = 0; r < 4; ++r)
#pragma unroll
        for (int i = 0; i < 16; ++i) acc[r][i] = 0.f;
#pragma unroll 4
    for (int j = 0; j < CK; ++j) {
        const float* wp = w_dw + j * CW + lane * 8;
        const f32x4 w0 = *(const f32x4*)wp, w1 = *(const f32x4*)(wp + 4), w2 = *(const f32x4*)(wp + 512), w3 = *(const f32x4*)(wp + 516);
        const float w[16] = {w0.x, w0.y, w0.z, w0.w, w1.x, w1.y, w1.z, w1.w, w2.x, w2.y, w2.z, w2.w, w3.x, w3.y, w3.z, w3.w};
#pragma unroll
        for (int r = 0; r < 4; ++r) {
            const LAS unsigned char* rowp = lds + (wid * 4 + r + j) * 2048 + lane * 16;
            const u32x4 a = *(const LAS u32x4*)rowp, b = *(const LAS u32x4*)(rowp + 1024);
            const float in[16] = {bflo(a.x), bfhi(a.x), bflo(a.y), bfhi(a.y), bflo(a.z), bfhi(a.z), bflo(a.w), bfhi(a.w),
                                  bflo(b.x), bfhi(b.x), bflo(b.y), bfhi(b.y), bflo(b.z), bfhi(b.z), bflo(b.w), bfhi(b.w)};
#pragma unroll
            for (int i = 0; i < 16; ++i) acc[r][i] += w[i] * in[i];
        }
    }
    {
        const float* bp = b_dw + lane * 8; const float* gp = ln_g + lane * 8; const float* lp = ln_b + lane * 8;
        const f32x4 b0 = *(const f32x4*)bp, b1 = *(const f32x4*)(bp + 4), b2 = *(const f32x4*)(bp + 512), b3 = *(const f32x4*)(bp + 516);
        const f32x4 g0 = *(const f32x4*)gp, g1 = *(const f32x4*)(gp + 4), g2 = *(const f32x4*)(gp + 512), g3 = *(const f32x4*)(gp + 516);
        const f32x4 l0 = *(const f32x4*)lp, l1 = *(const f32x4*)(lp + 4), l2 = *(const f32x4*)(lp + 512), l3 = *(const f32x4*)(lp + 516);
        const float bb[16] = {b0.x, b0.y, b0.z, b0.w, b1.x, b1.y, b1.z, b1.w, b2.x, b2.y, b2.z, b2.w, b3.x, b3.y, b3.z, b3.w};
        const float gg[16] = {g0.x, g0.y, g0.z, g0.w, g1.x, g1.y, g1.z, g1.w, g2.x, g2.y, g2.z, g2.w, g3.x, g3.y, g3.z, g3.w};
        const float ll[16] = {l0.x, l0.y, l0.z, l0.w, l1.x, l1.y, l1.z, l1.w, l2.x, l2.y, l2.z, l2.w, l3.x, l3.y, l3.z, l3.w};
#pragma unroll
        for (int r = 0; r < 4; ++r) {
            float s = 0.f;
#pragma unroll
            for (int i = 0; i < 16; ++i) { acc[r][i] += bb[i]; s += acc[r][i]; }
            const float mu = wave_sum(s) * (1.f / CW); float q = 0.f;
#pragma unroll
            for (int i = 0; i < 16; ++i) { acc[r][i] -= mu; q += acc[r][i] * acc[r][i]; }
            const float rstd = __builtin_amdgcn_rsqf(wave_sum(q) * (1.f / CW) + EPS);
            float o[16];
#pragma unroll
            for (int i = 0; i < 16; ++i) { const float y = acc[r][i] * rstd * gg[i] + ll[i]; o[i] = y * sigm(y); }
            bf16_t* op = YC + (size_t)(s0 + wid * 4 + r) * DM + lane * 8;
            u32x4 wa; wa.x = pk2(o[0], o[1]); wa.y = pk2(o[2], o[3]); wa.z = pk2(o[4], o[5]); wa.w = pk2(o[6], o[7]);
            u32x4 wb; wb.x = pk2(o[8], o[9]); wb.y = pk2(o[10], o[11]); wb.z = pk2(o[12], o[13]); wb.w = pk2(o[14], o[15]);
            *(u32x4*)op = wa; *(u32x4*)(op + 512) = wb;
        }
    }
    __syncthreads();
}

constexpr int SCHED_W = 3, SCHED_NSLOT = 69;
__device__ const unsigned short SCHED[256][SCHED_W] = {{350,191,65535},
{414,135,65535},
{478,190,65535},
{284,172,65535},
{285,199,65535},
{360,65535,65535},
{424,65535,65535},
{488,65535,65535},
{283,330,65535},
{411,163,65535},
{949,160,65535},
{164,1462,65535},
{286,263,65535},
{359,65535,65535},
{423,65535,65535},
{487,65535,65535},
{475,165,65535},
{1013,166,65535},
{161,1526,65535},
{147,57,1456},
{287,156,65535},
{358,65535,65535},
{422,65535,65535},
{486,65535,65535},
{892,325,51},
{948,106,58},
{107,59,1461},
{1012,108,60},
{288,158,65535},
{357,0,65535},
{421,256,65535},
{485,128,65535},
{109,52,1525},
{282,389,61},
{346,453,62},
{344,153,63},
{289,200,65535},
{356,322,65535},
{420,386,65535},
{484,450,65535},
{879,154,53},
{408,155,66},
{943,145,2},
{947,134,130},
{884,133,258},
{355,5,65535},
{419,387,65535},
{483,451,65535},
{157,54,1392},
{474,198,194},
{1011,146,129},
{159,1,1524},
{291,197,257},
{354,195,65535},
{418,259,65535},
{482,323,65535},
{882,458,65535},
{265,1395,65535},
{894,329,65535},
{946,201,65535},
{292,261,193},
{353,67,65535},
{417,131,65535},
{481,452,65535},
{393,1459,65535},
{1010,457,65535},
{264,65,1523},
{281,262,11},
{293,68,12},
{352,123,65535},
{416,124,65535},
{480,125,65535},
{345,326,6},
{881,390,13},
{454,14,1394},
{895,137,15},
{294,69,16},
{126,1407,65535},
{959,127,65535},
{1023,132,65535},
{409,138,3},
{945,139,17},
{136,18,1458},
{473,140,19},
{295,70,20},
{351,110,65535},
{958,196,65535},
{1022,260,65535},
{1009,141,4},
{142,21,1522},
{880,397,65535},
{461,1393,65535},
{296,71,22},
{111,1406,65535},
{324,1471,65535},
{388,1535,65535},
{944,268,65535},
{332,1457,65535},
{1008,396,65535},
{204,1521,65535},
{297,72,23},
{112,1405,65535},
{415,113,65535},
{479,114,65535},
{280,460,65535},
{883,267,65535},
{331,1396,65535},
{203,1460,65535},
{298,73,24},
{317,97,8},
{957,115,65535},
{1021,116,65535},
{893,395,65535},
{410,459,65535},
{266,1397,65535},
{472,202,192},
{299,74,25},
{98,321,1404},
{117,1470,65535},
{118,1534,65535},
{1007,162,55},
{394,64,1520},
{878,252,65535},
{248,1391,65535},
{300,75,26},
{99,320,1403},
{956,119,65535},
{1020,120,65535},
{942,253,65535},
{254,1455,65535},
{1006,255,65535},
{249,1519,65535},
{301,76,27},
{349,327,65535},
{121,1469,65535},
{122,1533,65535},
{279,206,65535},
{343,270,65535},
{877,334,65535},
{250,1390,65535},
{302,77,28},
{328,1402,65535},
{318,100,9},
{319,101,10},
{407,398,65535},
{941,462,65535},
{205,1454,65535},
{471,251,65535},
{303,78,29},
{888,148,65535},
{955,102,385},
{1019,103,449},
{1005,269,65535},
{333,1518,65535},
{876,236,65535},
{232,1389,65535},
{304,79,30},
{80,31,1401},
{104,384,1468},
{105,448,1532},
{940,237,65535},
{238,1453,65535},
{1004,239,65535},
{233,1517,65535},
{305,81,32},
{348,173,65535},
{954,149,65535},
{1018,143,65535},
{278,240,65535},
{342,241,65535},
{875,242,65535},
{234,1388,65535},
{306,82,33},
{887,174,65535},
{150,1467,65535},
{151,1531,65535},
{406,243,65535},
{939,244,65535},
{245,1452,65535},
{470,235,65535},
{307,83,34},
{175,1400,65535},
{413,391,65535},
{477,455,65535},
{1003,246,65535},
{247,1516,65535},
{874,220,65535},
{216,1387,65535},
{308,84,35},
{889,176,65535},
{953,392,65535},
{1017,456,65535},
{938,221,65535},
{222,1451,65535},
{1002,223,65535},
{217,1515,65535},
{309,85,36},
{886,177,65535},
{152,1466,65535},
{144,1530,65535},
{277,224,65535},
{341,225,65535},
{873,226,65535},
{218,1386,65535},
{310,86,37},
{178,1399,65535},
{952,87,38},
{1016,88,39},
{405,227,65535},
{937,228,65535},
{229,1450,65535},
{469,219,65535},
{311,89,40},
{890,179,65535},
{90,41,1465},
{91,42,1529},
{1001,230,65535},
{231,1514,65535},
{211,1385,65535},
{209,1449,65535},
{312,92,43},
{347,167,65535},
{412,180,65535},
{476,181,65535},
{212,1513,65535},
{276,213,65535},
{340,214,65535},
{404,210,65535},
{313,93,44},
{885,168,65535},
{951,182,65535},
{1015,183,65535},
{468,215,65535},
{275,466,65535},
{339,401,65535},
{403,337,65535},
{314,94,45},
{169,1398,65535},
{184,1464,65535},
{185,1528,65535},
{400,208,56},
{467,274,65535},
{338,402,65535},
{464,271,46},
{315,95,47},
{891,170,65535},
{950,186,65535},
{1014,187,65535},
{399,335,7},
{273,465,65535},
{272,207,48},
{336,463,49},
{316,96,50},
{290,171,65535},
{188,1463,65535},
{189,1527,65535}};
constexpr int SPLIT_H0 = 5, SPLIT_QB0 = 41, SPLIT_NQ = 23;
__device__ __forceinline__ int crow(int r, int hi) { return (r & 3) + 8 * (r >> 2) + 4 * hi; }
#define MFMA32(a, b, c) __builtin_amdgcn_mfma_f32_32x32x16_bf16((a), (b), (c), 0, 0, 0)
constexpr int ATT_KCH = 1040, ATT_VCH = 2064, ATT_VOFF = 16 * ATT_KCH, ATT_STAGE = 33280, ATT_QOFF = 2 * ATT_STAGE, ATT_QCH = 2064, ATT_EX = 0, MISC_OFF = 134144;
static_assert(ATT_VOFF + 8 * ATT_VCH <= ATT_STAGE && ATT_QOFF + 16 * ATT_QCH <= 131072 && 65536 <= ATT_QOFF && MISC_OFF + 64 <= LDS_BYTES && MISC_OFF >= 131072, "LDS map");
__device__ __forceinline__ void attn_unit(LAS unsigned char* lds, int type, int h, int qb, const bf16_t* Q, const bf16_t* Kg, const bf16_t* VT, bf16_t* YC,
                                          const float* subln_g, float lam, const unsigned* kmax2c, volatile LAS int* tstop_s, float* part, unsigned* flag, int tid, int wid, int lane) {
    const int r32 = lane & 31, hi = lane >> 5, qs = wid >> 1, m = wid & 1;
    const int q0 = qb * 128 + qs * 32, NT = 2 * qb + 2, tdg = 2 * qb + (qs >> 1);
    const int ttop = (type == 1) ? NT / 2 - 1 : NT - 1, tbot = (type == 2) ? NT / 2 : 0;
    const float sl2 = __builtin_amdgcn_exp2f(-(float)(h + 1)) * LOG2E;
#pragma unroll
    for (int i = 0; i < 4; ++i) { const int p = tid + 512 * i, row = p >> 4, ch = p & 15;
        *(LAS u32x4*)(lds + ATT_QOFF + ch * ATT_QCH + row * 16) = *(const u32x4*)(Q + (size_t)(qb * 128 + row) * AW + h * 128 + ch * 8); }
    const int qoff = ATT_QOFF + (m * 8 + hi) * ATT_QCH + (qs * 32 + r32) * 16;
    __syncthreads();
    float qkb;
    { float q2 = 0.f;
#pragma unroll
      for (int d0 = 0; d0 < 4; ++d0)
          { const bf16x8 qf = *(const LAS bf16x8*)(lds + qoff + d0 * 2 * ATT_QCH);
#pragma unroll
            for (int j = 0; j < 8; ++j) { const float v = __builtin_bit_cast(float, (unsigned)(unsigned short)qf[j] << 16); q2 += v * v; } }
      q2 += __shfl_xor(q2, 32);
      float k2 = 0.f;
#pragma unroll
      for (int c = 0; c < 8; ++c) k2 += __builtin_bit_cast(float, kmax2c[(h * 2 + m) * 8 + c]);
      qkb = __builtin_sqrtf(q2 * k2) * 1.002f + 1e-3f; }
    const int sig = (r32 & 0x13) | ((r32 & 8) >> 1) | ((r32 & 4) << 1);
    const int koff = (m * 8 + hi) * ATT_KCH + sig * 16;
    const int voff = ATT_VOFF + hi * ATT_VCH + r32 * 16;
    const int kr0 = 8 * wid + (lane >> 4), kc = lane & 15, ve0 = 16 * wid + (lane >> 3), vc = lane & 7;
    const int kw0 = kc * ATT_KCH + kr0 * 16, kw1 = kw0 + 4 * 16, vw0 = ATT_VOFF + vc * ATT_VCH + ve0 * 16, vw1 = vw0 + 8 * 16;
    const bf16_t* kg = Kg + (size_t)kr0 * AW + h * 128 + kc * 8;
    const bf16_t* vg = VT + (size_t)(h * 128 + ve0) * SEQ + vc * 8;
    f32x16 o[4];
    float lsum = 0.f, moff = 0.f;
    u32x4 sk0, sk1, sv0, sv1;
#define ATT_LOAD(t_) do { sk0 = *(const u32x4*)(kg + (size_t)(t_) * 64 * AW); sk1 = *(const u32x4*)(kg + (size_t)((t_) * 64 + 4) * AW); \
                          sv0 = *(const u32x4*)(vg + (t_) * 64); sv1 = *(const u32x4*)(vg + (size_t)8 * SEQ + (t_) * 64); } while (0)
#define ATT_STORE(sp_) do { *(LAS u32x4*)((sp_) + kw0) = sk0; *(LAS u32x4*)((sp_) + kw1) = sk1; *(LAS u32x4*)((sp_) + vw0) = sv0; *(LAS u32x4*)((sp_) + vw1) = sv1; } while (0)
#define ATT_RESCALE(f_) do { _Pragma("unroll") for (int eb = 0; eb < 4; ++eb) _Pragma("unroll") for (int r = 0; r < 16; ++r) o[eb][r] *= (f_); } while (0)
#define ATT_EXP_PV() do { float ls = 0.f; \
        _Pragma("unroll") for (int r = 0; r < 16; ++r) { p0[r] = __builtin_amdgcn_exp2f(p0[r]); p1[r] = __builtin_amdgcn_exp2f(p1[r]); ls += p0[r] + p1[r]; } \
        lsum += ls; u32x4 pw[4]; \
        _Pragma("unroll") for (int j = 0; j < 4; ++j) { pw[0][j] = pk2(p0[2 * j], p0[2 * j + 1]); pw[1][j] = pk2(p0[8 + 2 * j], p0[9 + 2 * j]); pw[2][j] = pk2(p1[2 * j], p1[2 * j + 1]); pw[3][j] = pk2(p1[8 + 2 * j], p1[9 + 2 * j]); } \
        _Pragma("unroll") for (int ks = 0; ks < 4; ++ks) { const bf16x8 pa = __builtin_bit_cast(bf16x8, pw[ks]); \
            _Pragma("unroll") for (int eb = 0; eb < 4; ++eb) { const bf16x8 vf = *(const LAS bf16x8*)(st + voff + ks * 2 * ATT_VCH + eb * 512); o[eb] = MFMA32(vf, pa, o[eb]); } } } while (0)
    int nit; float mdiag;
    {
        if (tid == 0) *tstop_s = 0x7fffffff;
        {
          const u32x4 ka0 = *(const u32x4*)(kg + (size_t)(NT - 1) * 64 * AW), ka1 = *(const u32x4*)(kg + (size_t)((NT - 1) * 64 + 4) * AW);
          const u32x4 kb0 = *(const u32x4*)(kg + (size_t)(NT - 2) * 64 * AW), kb1 = *(const u32x4*)(kg + (size_t)((NT - 2) * 64 + 4) * AW);
          *(LAS u32x4*)(lds + kw0) = ka0; *(LAS u32x4*)(lds + kw1) = ka1; *(LAS u32x4*)(lds + ATT_STAGE + kw0) = kb0; *(LAS u32x4*)(lds + ATT_STAGE + kw1) = kb1; }
        __syncthreads();
        LAS unsigned char* st = lds + ((qs < 2) ? ATT_STAGE : 0);
        f32x16 p0, p1;
#pragma unroll
        for (int r = 0; r < 16; ++r) { p0[r] = 0.f; p1[r] = 0.f; }
#pragma unroll
        for (int d0 = 0; d0 < 4; ++d0) {
            const bf16x8 a0 = *(const LAS bf16x8*)(st + koff + d0 * 2 * ATT_KCH), a1 = *(const LAS bf16x8*)(st + koff + d0 * 2 * ATT_KCH + 512);
            const bf16x8 qf = *(const LAS bf16x8*)(lds + qoff + d0 * 2 * ATT_QCH);
            p0 = MFMA32(a0, qf, p0); p1 = MFMA32(a1, qf, p1);
        }
        const float dbase = (float)(q0 + r32 - tdg * 64 - 8 * hi);
        float mx = -3e38f;
#pragma unroll
        for (int r = 0; r < 16; ++r) { const float c = (float)(16 * (r >> 3) + (r & 7));
            mx = __builtin_fmaxf(mx, __builtin_fmaxf(__builtin_fmaf(-sl2, __builtin_fabsf(dbase - c), p0[r]), __builtin_fmaf(-sl2, __builtin_fabsf(dbase - (c + 32.f)), p1[r]))); }
        mx = __builtin_fmaxf(mx, __shfl_xor(mx, 32));
        mdiag = mx;
        float b = qkb - mx;
#pragma unroll
        for (int x = 1; x < 32; x <<= 1) b = __builtin_fmaxf(b, __shfl_xor(b, x));
        const float ts = ((float)(q0 - 63) - (b + 136.f) / sl2) * (1.f / 64.f);
        int tsi = (ts > 0.f) ? (int)__builtin_ceilf(ts) : 0; if (!(ts == ts)) tsi = 0;
        if (lane == 0) __hip_atomic_fetch_min((LAS int*)tstop_s, tsi, __ATOMIC_RELAXED, __HIP_MEMORY_SCOPE_WORKGROUP);
        __syncthreads();
        const int tsw = *tstop_s, tlast = tsw > tbot ? tsw : tbot; nit = ttop - tlast + 1; if (nit < 0) nit = 0;
        __syncthreads();
    }
    if (wid >= 4) __builtin_amdgcn_s_setprio(1);
    for (;;) {
#pragma unroll
    for (int eb = 0; eb < 4; ++eb)
#pragma unroll
        for (int r = 0; r < 16; ++r) o[eb][r] = 0.f;
    lsum = 0.f;
    const float mref = mdiag + moff;
    if (nit > 0) { ATT_LOAD(ttop); ATT_STORE(lds); }
    __syncthreads();
    for (int it = 0; it < nit; ++it) {
        const int t = ttop - it; LAS unsigned char* st = lds + (it & 1) * ATT_STAGE;
        const bool more = (it + 1 < nit);
        if (more) ATT_LOAD(t - 1);
        if (t <= tdg) {
            const bool diag = (t == tdg);
            const float dbase = (float)(q0 + r32 - t * 64 - 8 * hi);
            const float A = diag ? -mref : (-sl2 * dbase - mref), sl = diag ? 0.f : sl2;
            f32x16 p0, p1;
#pragma unroll
            for (int r = 0; r < 16; ++r) { const float c = (float)(16 * (r >> 3) + (r & 7)); p0[r] = __builtin_fmaf(sl, c, A); p1[r] = __builtin_fmaf(sl, c + 32.f, A); }
#pragma unroll
            for (int d0 = 0; d0 < 4; ++d0) {
                const bf16x8 a0 = *(const LAS bf16x8*)(st + koff + d0 * 2 * ATT_KCH), a1 = *(const LAS bf16x8*)(st + koff + d0 * 2 * ATT_KCH + 512);
                const bf16x8 qf = *(const LAS bf16x8*)(lds + qoff + d0 * 2 * ATT_QCH);
                p0 = MFMA32(a0, qf, p0); p1 = MFMA32(a1, qf, p1);
            }
            if (diag) {
#pragma unroll
                for (int r = 0; r < 16; ++r) { const float c = (float)(16 * (r >> 3) + (r & 7));
                    p0[r] = __builtin_fmaf(-sl2, __builtin_fabsf(dbase - c), p0[r]); p1[r] = __builtin_fmaf(-sl2, __builtin_fabsf(dbase - (c + 32.f)), p1[r]); }
            }
            ATT_EXP_PV();
        }
        if (more) ATT_STORE(lds + ((it + 1) & 1) * ATT_STAGE);
        __syncthreads();
    }
    lsum += __shfl_xor(lsum, 32);
    const bool bad = !(lsum <= 1.1529215e18f);
    if (!__syncthreads_or(bad ? 1 : 0)) break;
    if (bad) moff += 60.f;
    }
    __builtin_amdgcn_s_setprio(0);
#undef ATT_LOAD
#undef ATT_STORE
#undef ATT_EXP_PV
    if (type == 1) {
        float* pp = part + (size_t)wid * 4096 + lane;
#pragma unroll
        for (int eb = 0; eb < 4; ++eb)
#pragma unroll
            for (int r = 0; r < 16; ++r) pp[(eb * 16 + r) * 64] = o[eb][r];
        part[32768 + wid * 64 + lane] = lsum; part[32768 + 512 + wid * 64 + lane] = moff;
        asm volatile("s_waitcnt vmcnt(0)" ::: "memory");
        __syncthreads();
        if (tid == 0) { __builtin_amdgcn_fence(__ATOMIC_RELEASE, "agent"); asm volatile("s_waitcnt vmcnt(0)" ::: "memory");
                        __hip_atomic_store(flag, 1u, __ATOMIC_RELAXED, __HIP_MEMORY_SCOPE_AGENT); }
        __syncthreads();
    } else {
    if (type == 2) {
        if (tid == 0) { unsigned sp = 0;
            while (__hip_atomic_load(flag, __ATOMIC_RELAXED, __HIP_MEMORY_SCOPE_AGENT) == 0u) { __builtin_amdgcn_s_sleep(8); if (++sp > (1u << 22)) break; }
            __builtin_amdgcn_fence(__ATOMIC_ACQUIRE, "agent"); asm volatile("s_waitcnt vmcnt(0)" ::: "memory"); }
        __syncthreads();
        const float lf = part[32768 + wid * 64 + lane], mf = part[32768 + 512 + wid * 64 + lane];
        const float R = __builtin_fmaxf(moff, mf), sn = __builtin_amdgcn_exp2f(moff - R), sf = __builtin_amdgcn_exp2f(mf - R);
        const float* pp = part + (size_t)wid * 4096 + lane;
#pragma unroll
        for (int eb = 0; eb < 4; ++eb)
#pragma unroll
            for (int r = 0; r < 16; ++r) o[eb][r] = o[eb][r] * sn + pp[(eb * 16 + r) * 64] * sf;
        lsum = lsum * sn + lf * sf;
    }
    { float inv = 1.f / lsum; if (m == 1) inv *= lam; ATT_RESCALE(inv); }
    LAS float* ex = (LAS float*)(lds + ATT_EX + qs * 16384);
    if (m == 1) {
#pragma unroll
        for (int eb = 0; eb < 4; ++eb)
#pragma unroll
            for (int r = 0; r < 16; ++r) ex[(eb * 16 + r) * 64 + lane] = o[eb][r];
    }
    __syncthreads();
    if (m == 0) {
        float ss = 0.f;
#pragma unroll
        for (int eb = 0; eb < 4; ++eb)
#pragma unroll
            for (int r = 0; r < 16; ++r) { o[eb][r] -= ex[(eb * 16 + r) * 64 + lane]; ss += o[eb][r] * o[eb][r]; }
        ss += __shfl_xor(ss, 32);
        const float rs = __builtin_amdgcn_rsqf(ss * (1.f / 128.f) + EPS) * 0.8f;
        bf16_t* op = YC + (size_t)(q0 + r32) * DM + CW + h * 128 + 4 * hi;
#pragma unroll
        for (int eb = 0; eb < 4; ++eb)
#pragma unroll
            for (int g4 = 0; g4 < 4; ++g4) { const int e0 = eb * 32 + 8 * g4; const f32x4 gv = *(const f32x4*)(subln_g + e0 + 4 * hi);
                u32x2 w; w.x = pk2(o[eb][4 * g4] * rs * gv.x, o[eb][4 * g4 + 1] * rs * gv.y); w.y = pk2(o[eb][4 * g4 + 2] * rs * gv.z, o[eb][4 * g4 + 3] * rs * gv.w);
                *(u32x2*)(op + e0) = w; }
    }
    __syncthreads();
    }
#undef ATT_RESCALE
}

#define RLX_AGENT __ATOMIC_RELAXED, __HIP_MEMORY_SCOPE_AGENT
#define XB_TMO      128
#define XB_XCNT(j)  (256  + 64 * (j))
#define XB_XSUB(j)  (1280 + 64 * (j))
#define XB_XGEN(j)  (2304 + 64 * (j))
#define XB_TOP      3328
#define XB_TOPGEN   3392
#define XCD_BAR_WORDS 3456
#define XB_SPIN_CAP (1u << 18)

__device__ __forceinline__ unsigned xb_ld(unsigned* p)              { return __hip_atomic_load(p, __ATOMIC_RELAXED, __HIP_MEMORY_SCOPE_AGENT); }
__device__ __forceinline__ unsigned xb_add(unsigned* p, unsigned v) { return __hip_atomic_fetch_add(p, v, __ATOMIC_RELAXED, __HIP_MEMORY_SCOPE_AGENT); }
__device__ __forceinline__ unsigned xb_xcc_id() { return (unsigned)__builtin_amdgcn_s_getreg((3 << 11) | 20) & 0xFu; }
#define XB_SPIN(cond, bar) do { unsigned _sp = 0; while (cond) { __builtin_amdgcn_s_sleep(1); \
    if ((++_sp & 255u) == 0u) { if (xb_ld(&(bar)[XB_TMO])) break; if (_sp > XB_SPIN_CAP) { atomicAdd(&(bar)[XB_TMO], 1u); break; } } } } while (0)

struct XcdBarrier {
    unsigned* bar; unsigned x;
    volatile LAS unsigned* st;
};
__device__ __forceinline__ XcdBarrier xcd_barrier_post(unsigned* bar, volatile LAS unsigned* st) {
    XcdBarrier b; b.bar = bar; b.x = xb_xcc_id(); b.st = st;
    if (threadIdx.x == 0) (void)xb_add(&bar[XB_XCNT(b.x)], 1u);
    return b;
}
__device__ __forceinline__ void xcd_barrier_complete(unsigned* bar, unsigned x, unsigned& nloc, unsigned& nx) {
    const unsigned G = gridDim.x * gridDim.y * gridDim.z;
    unsigned sum, cnt, mine, sp = 0u;
    for (;;) {
        sum = 0u; cnt = 0u; mine = 0u;
#pragma unroll
        for (unsigned j = 0; j < 16; ++j) { const unsigned c = xb_ld(&bar[XB_XCNT(j)]); sum += c; cnt += (c > 0u) ? 1u : 0u; mine = (j == x) ? c : mine; }
        if (sum == G) break;
        __builtin_amdgcn_s_sleep(1);
        if ((++sp & 255u) == 0u) { if (xb_ld(&bar[XB_TMO])) break; if (sp > XB_SPIN_CAP) { atomicAdd(&bar[XB_TMO], 1u); break; } }
    }
    nloc = mine > 0u ? mine : 1u; nx = cnt > 0u ? cnt : 1u;
}

__device__ __forceinline__ void xcd_barrier(const XcdBarrier& b) {
    asm volatile("s_waitcnt vmcnt(0)" ::: "memory");
    __syncthreads();
    if (threadIdx.x == 0) {
        unsigned* bar = b.bar;
        __builtin_amdgcn_s_waitcnt(0);
        unsigned nloc = b.st[0], nx = b.st[1];
        if (nloc == 0u) { xcd_barrier_complete(bar, b.x, nloc, nx); b.st[0] = nloc; b.st[1] = nx; }
        const unsigned old = xb_add(&bar[XB_XSUB(b.x)], 1u);
        const unsigned gen = old / nloc;
        if (old + 1u == (gen + 1u) * nloc) {
            __builtin_amdgcn_fence(__ATOMIC_RELEASE, "agent");
            asm volatile("s_waitcnt vmcnt(0)" ::: "memory");
            const unsigned og = xb_add(&bar[XB_TOP], 1u);
            const unsigned tg = og / nx;
            if (og + 1u == (tg + 1u) * nx) xb_add(&bar[XB_TOPGEN], 1u);
            else XB_SPIN(xb_ld(&bar[XB_TOPGEN]) == tg, bar);
            __builtin_amdgcn_fence(__ATOMIC_ACQUIRE, "agent");
            xb_add(&bar[XB_XGEN(b.x)], 1u);
            asm volatile("s_waitcnt vmcnt(0)" ::: "memory");
        } else {
            XB_SPIN(xb_ld(&bar[XB_XGEN(b.x)]) == gen, bar);
            __builtin_amdgcn_fence(__ATOMIC_ACQUIRE, "agent");
            asm volatile("s_waitcnt vmcnt(0)" ::: "memory");
        }
    }
    __syncthreads();
}
struct Args { const float* in[24]; float* out; unsigned char* ws; int ph_lo, ph_hi; };
enum { I_X = 0, I_C, I_WADA, I_BADA, I_GPRE, I_GPOST, I_W1G, I_W1U, I_W1D, I_WIN, I_BIN, I_WDW, I_BDW, I_LNG, I_LNB, I_LQ1, I_LK1, I_LQ2, I_LK2, I_SUBG, I_WOUT, I_W2G, I_W2U, I_W2D };

__global__ void __launch_bounds__(512) fwd_kernel(Args args) {
    extern __shared__ __attribute__((aligned(16))) unsigned char lds_raw[];
    LAS unsigned char* lds = (LAS unsigned char*)lds_raw;
    cg::grid_group grid = cg::this_grid();
    const int tid = threadIdx.x, lane = tid & 63, wid = __builtin_amdgcn_readfirstlane(tid >> 6);
    const int G = gridDim.x, bx = blockIdx.x;
    const int vcu = (G % 8 == 0) ? (bx % 8) * (G / 8) + bx / 8 : bx;
    const int gw = vcu * 8 + wid, NGW = G * 8;
    unsigned char* ws = args.ws;
    const float* x = args.in[I_X];
    float* modp = (float*)(ws + WS_MODP);
    bf16_t* Wgu1 = (bf16_t*)(ws + WS_WGU1); bf16_t* Wd1 = (bf16_t*)(ws + WS_WD1); bf16_t* Win = (bf16_t*)(ws + WS_WIN); bf16_t* Wout = (bf16_t*)(ws + WS_WOUT);
    bf16_t* Wgu2 = (bf16_t*)(ws + WS_WGU2); bf16_t* Wd2 = (bf16_t*)(ws + WS_WD2);
    bf16_t* Hb = (bf16_t*)(ws + WS_H); bf16_t* ACT = (bf16_t*)(ws + WS_ACT);
    bf16_t* VGb = (bf16_t*)(ws + WS_VG); bf16_t* Qb = (bf16_t*)(ws + WS_Q); bf16_t* Kb = (bf16_t*)(ws + WS_K); bf16_t* VTb = (bf16_t*)(ws + WS_VT); bf16_t* YC = (bf16_t*)(ws + WS_YCAT);
    bf16_t* Yh = (bf16_t*)(ws + WS_Y); float* X1 = (float*)(ws + WS_X1);
    const float* b_ada = args.in[I_BADA]; const float* g_pre = args.in[I_GPRE]; const float* g_post = args.in[I_GPOST];
    const int lo = args.ph_lo, hi_ = args.ph_hi;
    WPtrs WP; WP.w1g = args.in[I_W1G]; WP.w1u = args.in[I_W1U]; WP.w1d = args.in[I_W1D]; WP.win = args.in[I_WIN]; WP.wout = args.in[I_WOUT]; WP.w2g = args.in[I_W2G]; WP.w2u = args.in[I_W2U]; WP.w2d = args.in[I_W2D];
    WP.Wgu1 = Wgu1; WP.Wd1 = Wd1; WP.Win = Win; WP.Wout = Wout; WP.Wgu2 = Wgu2; WP.Wd2 = Wd2;
    volatile LAS unsigned* MISC = (volatile LAS unsigned*)(lds + MISC_OFF);
    if (tid < 16) MISC[tid] = 0u;
    __syncthreads();
    XcdBarrier bar; bar.bar = (unsigned*)ws; bar.x = 0; bar.st = nullptr;
    if (!MK_SPLIT) bar = xcd_barrier_post((unsigned*)ws, MISC);
    if (hi_ > NPHASE + 7) grid.sync();
#ifndef PROBE_DUP
#define PROBE_DUP -1
#endif
#define IN(k) (lo <= (k) && (k) < hi_)
#define SEAM(k) do { if (IN(k) && IN((k) + 1)) xcd_barrier(bar); } while (0)

    if (IN(0)) {
        const float* c = args.in[I_C]; const float* w_ada = args.in[I_WADA];
        for (int it = gw; it < 72 * KSPLIT; it += NGW) {
            const int cc = it % 72, ks = it / 72;
            const float* wp = w_ada + (size_t)(ks * 128) * NMODW + cc * 256 + lane * 4;
            f32x4 a = (f32x4){0.f, 0.f, 0.f, 0.f};
#pragma unroll 8
            for (int k = 0; k < 128; ++k) { const float cv = c[ks * 128 + k]; const float sv = cv * sigm(cv); a += __builtin_nontemporal_load((const f32x4*)(wp + (size_t)k * NMODW)) * sv; }
            *(f32x4*)(modp + (size_t)ks * NMODW + cc * 256 + lane * 4) = a;
        }
        LAS float* scr = (LAS float*)(lds + wid * 16384);
        tr_run<false>(WP, gw, NGW, scr, lane, 0, (G == 256) ? NITEMS_A - I_GU - I_IN / 2 : NITEMS_A);
        __syncthreads();
    }
    SEAM(0);
    if (IN(1)) { float* modfull = (float*)(ws + 3 * MiB);
        for (int i = bx * 512 + tid; i < NMODW / 4; i += G * 512) *(f32x4*)(modfull + 4 * i) = mod4(modp, b_ada, 4 * i); }
    if (IN(1)) row_phase<false, true, false>(lds, gw, NGW, tid, lane, nullptr, x, nullptr, Hb, modp, b_ada, nullptr, 0, 0.f, g_pre, 0, 1);
    SEAM(1);
    if (IN(2)) {
        const int Gg = (G == 256) ? 240 : G;
        if (bx < Gg) { pg8::Gemm g{Hb, Wgu1, SEQ, 2 * DFF, DM}; pg8::StaticOrder S; S.init(SEQ, 2 * DFF, Gg, bx); EpiSwiGLU E{ACT, DFF};
            pg8::gemm_phase<EpiSwiGLU, pg8::StaticOrder, PG8_ALIGN, PG8_SP2>(lds, g, S, E); }
        else { LAS float* scr = (LAS float*)(lds + wid * 16384); tr_run<false>(WP, (bx - Gg) * 8 + wid, (G - Gg) * 8, scr, lane, NITEMS_A - I_GU - I_IN / 2, NITEMS_A); __syncthreads(); }
    }
    SEAM(2);
    if (IN(3)) { pg8::Gemm g{ACT, Wd1, SEQ, DM, DFF}; pg8::StaticOrder S; S.init(SEQ, DM, G, bx); EpiBf16Plain E{Yh, DM};
        pg8::gemm_phase<EpiBf16Plain, pg8::StaticOrder, PG8_ALIGN, PG8_SP2>(lds, g, S, E); }
    SEAM(3);
    if (IN(4)) row_phase<true, true, true, false, true>(lds, gw, NGW, tid, lane, Yh, x, X1, Hb, (const float*)(ws + 3 * MiB), b_ada, g_post, 2, 0.5f, g_pre + DM, 3, 4);
    SEAM(4);
    if (IN(5)) {
        { pg8::Gemm g{Hb, Win, SEQ, 4096, DM}; pg8::StaticOrder S; S.init(SEQ, 4096, G, bx); EpiInProj E{VGb, Qb, Kb, args.in[I_BIN], (unsigned*)(ws + 16384)};
          pg8::gemm_phase<EpiInProj, pg8::StaticOrder, PG8_ALIGN, PG8_SP2>(lds, g, S, E); }
        { pg8::Gemm g{Win + (size_t)4096 * DM, Hb, AW, SEQ, DM}; pg8::StaticOrder S; S.init(AW, SEQ, G, bx); EpiBf16Plain E{VTb, SEQ};
          pg8::gemm_phase<EpiBf16Plain, pg8::StaticOrder, PG8_ALIGN, PG8_SP2>(lds, g, S, E); }
        { constexpr int NU = (AW / 256) * (SEQ / 256); const int nbusy = NU < G ? NU : G;
          LAS float* scr = (LAS float*)(lds + wid * 16384);
          const bool all = (nbusy == G);
          if (all || bx >= nbusy) { tr_run<true>(WP, all ? gw : (bx - nbusy) * 8 + wid, all ? NGW : (G - nbusy) * 8, scr, lane); __syncthreads(); } }
    }
    SEAM(5);
    if (IN(6)) {
        for (int u = vcu; u < SEQ / 32; u += G) conv_unit(lds, 32 * u, VGb, args.in[I_WDW], args.in[I_BDW], args.in[I_LNG], args.in[I_LNB], YC, tid, wid, lane);
        float lam;
        { const float a = wave_sum(args.in[I_LQ1][lane] * args.in[I_LK1][lane]), b = wave_sum(args.in[I_LQ2][lane] * args.in[I_LK2][lane]);
          lam = __expf(a) - __expf(b) + 0.2f; }
#pragma unroll 1
        for (int wg = bx; wg < 256; wg += G)
#pragma unroll 1
            for (int k = 0; k < SCHED_W; ++k) { const unsigned code = SCHED[wg][k]; if (code == 0xFFFFu) break;
                const int type = (int)(code >> 9), h = (int)((code >> 6) & 7), qb = (int)(code & 63);
                int slot = (h - SPLIT_H0) * SPLIT_NQ + (qb - SPLIT_QB0); if (type == 0 || slot < 0 || slot >= SCHED_NSLOT) slot = 0;
                attn_unit(lds, type, h, qb, Qb, Kb, VTb, YC, args.in[I_SUBG], lam, (const unsigned*)(ws + 16384), (volatile LAS int*)(MISC + 12),
                          (float*)(ws + WS_PART) + (size_t)slot * PART_FLOATS, (unsigned*)(ws + 20480) + slot, tid, wid, lane); }
    }
    SEAM(6);
    if (IN(7)) { pg8::Gemm g{YC, Wout, SEQ, DM, DM}; pg8::StaticOrder S; S.init(SEQ, DM, G, bx); EpiBf16Plain E{Yh, DM};
        pg8::gemm_phase<EpiBf16Plain, pg8::StaticOrder, PG8_ALIGN, PG8_SP2>(lds, g, S, E); }
    SEAM(7);
    if (IN(8)) row_phase<true, true, true, true, true>(lds, gw, NGW, tid, lane, Yh, X1, X1, Hb, (const float*)(ws + 3 * MiB), b_ada, g_post + DM, 5, 1.f, g_pre + 2 * DM, 6, 7);
    SEAM(8);
    if (IN(9)) { pg8::Gemm g{Hb, Wgu2, SEQ, 2 * DFF, DM}; pg8::StaticOrder S; S.init(SEQ, 2 * DFF, G, bx); EpiSwiGLU E{ACT, DFF};
        pg8::gemm_phase<EpiSwiGLU, pg8::StaticOrder, PG8_ALIGN, PG8_SP2>(lds, g, S, E); }
    SEAM(9);
    if (IN(10)) { pg8::Gemm g{ACT, Wd2, SEQ, DM, DFF}; pg8::StaticOrder S; S.init(SEQ, DM, G, bx); EpiBf16Plain E{Yh, DM};
        pg8::gemm_phase<EpiBf16Plain, pg8::StaticOrder, PG8_ALIGN, PG8_SP2>(lds, g, S, E); }
    SEAM(10);
    if (IN(11)) row_phase<true, false, true, true, false>(lds, gw, NGW, tid, lane, Yh, X1, args.out, nullptr, (const float*)(ws + 3 * MiB), b_ada, g_post + 2 * DM, 8, 0.5f, nullptr, 0, 0);
#undef IN
#undef SEAM
}

extern "C" void kernel_launch(void* const* d_in, const int* in_sizes, int n_in, void* d_out, int out_size, void* d_ws, size_t ws_size, hipStream_t stream) {
    static int grid = 0;
    if (grid == 0) {
        if (n_in != 24 || in_sizes[0] != SEQ * DM || out_size != SEQ * DM || ws_size < WS_END) { fprintf(stderr, "kernel_launch: unexpected shapes / workspace (n_in %d, ws %zu)\n", n_in, ws_size); grid = -1; return; }
        int dev = 0, cus = 0, per_cu = 0;
        if (hipGetDevice(&dev) != hipSuccess || hipDeviceGetAttribute(&cus, hipDeviceAttributeMultiprocessorCount, dev) != hipSuccess) { grid = -1; return; }
        if (hipFuncSetAttribute((const void*)fwd_kernel, hipFuncAttributeMaxDynamicSharedMemorySize, LDS_BYTES) != hipSuccess) { fprintf(stderr, "kernel_launch: hipFuncSetAttribute failed\n"); grid = -1; return; }
        if (hipOccupancyMaxActiveBlocksPerMultiprocessor(&per_cu, (const void*)fwd_kernel, 512, LDS_BYTES) != hipSuccess || per_cu < 1) { fprintf(stderr, "kernel_launch: occupancy query says %d\n", per_cu); per_cu = 1; }
        (void)hipGetLastError();
        grid = cus * 1;
        if (grid > 256) grid = 256;
    }
    if (grid < 0) return;
    if (hipMemsetAsync(d_ws, 0, 32768, stream) != hipSuccess) { fprintf(stderr, "kernel_launch: memset failed\n"); return; }
    Args a{};
    for (int i = 0; i < 24; ++i) a.in[i] = (const float*)d_in[i];
    a.out = (float*)d_out; a.ws = (unsigned char*)d_ws;
#if MK_SPLIT
    for (int p = 0; p < NPHASE; ++p) { a.ph_lo = p; a.ph_hi = p + 1; for (int r = 0; r < (p == PROBE_DUP ? 2 : 1); ++r) hipLaunchKernelGGL(fwd_kernel, dim3(grid), dim3(512), LDS_BYTES, stream, a); }
#else
    a.ph_lo = 0; a.ph_hi = NPHASE;
    void* kargs[] = {&a};
    hipError_t e = hipLaunchCooperativeKernel((const void*)fwd_kernel, dim3(grid), dim3(512), kargs, LDS_BYTES, stream);
    if (e != hipSuccess) fprintf(stderr, "kernel_launch: cooperative launch failed: %s (grid %d)\n", hipGetErrorString(e), grid);
#endif
}
```

```cpp
#include <hip/hip_runtime.h>
#include <hip/hip_cooperative_groups.h>
#include <cstdio>
#include <cstdint>
namespace cg = cooperative_groups;
namespace pg8 {
#define PG8_LAS __attribute__((address_space(3)))
typedef unsigned short bf16_t;
typedef short bf16x8 __attribute__((ext_vector_type(8)));
typedef float f32x4 __attribute__((ext_vector_type(4)));
typedef unsigned u32x4 __attribute__((ext_vector_type(4)));
constexpr int BM = 256, BK = 64, HALF = 128, HTB = HALF * BK * 2  , STAGE_BYTES = 8 * HTB, NXCD = 8, WGM = 4;

__host__ __device__ __forceinline__ int lds_byte(int r, int c) { const int st = (r >> 4) * 2 + (c >> 5), rr = r & 15, cc = c & 31, ob = rr * 64 + cc * 2; return st * 1024 + (ob ^ (((ob >> 9) & 1) << 5)); }
__host__ __device__ __forceinline__ void stage_rc(int b, int& R, int& C) { const int st = b / 1024, sb = b % 1024, swz = sb ^ (((sb >> 9) & 1) << 5); R = (st >> 1) * 16 + swz / 64; C = (st & 1) * 32 + (swz % 64) / 2; }
__host__ __device__ __forceinline__ int perm32(int rho) { const int n = rho >> 4, i = rho & 15; return 8 * (i >> 2) + 4 * n + (i & 3); }

struct Unit { int pm, pn; };
struct Gemm { const bf16_t* A; const bf16_t* Bt; int M, N, K; };

struct StaticOrder {
    int nM, nN, nwg, G, c;
    __host__ __device__ void init(int M, int N, int G_, int c_) { nM = M / BM; nN = N / BM; nwg = nM * nN; G = G_; c = c_; }
    __host__ __device__ bool next(int i, Unit& u) const {
        const long L = (long)i * G + c; if (L >= nwg) return false;
        int wgid = (int)L; { const int q = nwg / NXCD, r = nwg % NXCD, xcd = wgid % NXCD, off = wgid / NXCD; wgid = (xcd < r ? xcd * (q + 1) : r * (q + 1) + (xcd - r) * q) + off; }
        const int nig = WGM * nN, gid = wgid / nig, fm = gid * WGM, gsz = (nM - fm) < WGM ? (nM - fm) : WGM;
        u.pm = fm + ((wgid % nig) % gsz); u.pn = (wgid % nig) / gsz; return true;
    }
    __device__ __forceinline__ void a_ready(const Unit&) const {}
    __device__ __forceinline__ void done(const Unit&) const {}
};

__device__ __forceinline__ unsigned cvt_pk_bf16(float lo, float hi) { unsigned r; asm volatile("v_cvt_pk_bf16_f32 %0, %1, %2" : "=v"(r) : "v"(lo), "v"(hi)); return r; }
typedef float f32x2 __attribute__((ext_vector_type(2)));
template <class Epi, class Sched, bool ALIGN_EPI = false, bool SP2 = false>
__device__ __forceinline__ void gemm_phase(PG8_LAS unsigned char* lds, const Gemm g, const Sched& S, const Epi& E) {
    const int tid = threadIdx.x, wid = __builtin_amdgcn_readfirstlane(tid >> 6), lane = tid & 63, wr = wid >> 2, wc = wid & 3, fr = lane & 15, fq = lane >> 4;
    const int K = g.K, nt = K / BK;
    unsigned voffA[2], voffB[2];
#pragma unroll
    for (int i = 0; i < 2; ++i) { int R, C; stage_rc(tid * 16 + i * 8192, R, C); const int Rb = Epi::PERM ? ((R & ~31) + perm32(R & 31)) : R;
        voffA[i] = (unsigned)(R * K + C) * 2u; voffB[i] = (unsigned)(Rb * K + C) * 2u; }
    const size_t kstep = (size_t)(BK * 2);
    const size_t hstep = (size_t)HALF * K * 2;
    const size_t tstep = 2 * hstep;
    const unsigned ldsw = (unsigned)wid * 1024u;
    const int aoff = lds_byte(wr * 64 + fr, fq * 8), boff = lds_byte(wc * 32 + fr, fq * 8);
#define PG8_SA(b, h) (((b) * 2 + (h)) * HTB)
#define PG8_SB(b, h) ((4 + (b) * 2 + (h)) * HTB)
#define PG8_STAGE(bufoff, gbase, voff) do { _Pragma("unroll") for (int _i = 0; _i < 2; ++_i) \
        __builtin_amdgcn_global_load_lds((const unsigned*)((const char*)(gbase) + (voff)[_i]), (PG8_LAS unsigned*)(lds + (bufoff) + ldsw + _i * 8192), 16, 0, 0); } while (0)
#define PG8_LDA(dst, b, h) do { _Pragma("unroll") for (int m = 0; m < 4; ++m) _Pragma("unroll") for (int k = 0; k < 2; ++k) dst[m][k] = *(const PG8_LAS bf16x8*)(lds + PG8_SA(b, h) + aoff + m * 2048 + k * 1024); } while (0)
#define PG8_LDB(dst, b, h) do { _Pragma("unroll") for (int n = 0; n < 2; ++n) _Pragma("unroll") for (int k = 0; k < 2; ++k) dst[n][k] = *(const PG8_LAS bf16x8*)(lds + PG8_SB(b, h) + boff + n * 2048 + k * 1024); } while (0)
#define PG8_MMA(ai, bj, At, Bt) do { __builtin_amdgcn_s_setprio(1); _Pragma("unroll") for (int m = 0; m < 4; ++m) _Pragma("unroll") for (int n = 0; n < 2; ++n) _Pragma("unroll") for (int k = 0; k < 2; ++k) \
        acc[ai][bj][m][n] = __builtin_amdgcn_mfma_f32_16x16x32_bf16(Bt[n][k], At[m][k], acc[ai][bj][m][n], 0, 0, 0); __builtin_amdgcn_s_setprio(0); } while (0)
#define PG8_WAIT_V(n) asm volatile("s_waitcnt vmcnt(" #n ")" ::: "memory")
#define PG8_WAIT_L(n) asm volatile("s_waitcnt lgkmcnt(" #n ")" ::: "memory")
#define PG8_BAR __builtin_amdgcn_s_barrier()
#define PG8_SCHED __builtin_amdgcn_sched_barrier(0)
    Unit cur, nxt; int ui = 0;
    if (!S.next(0, cur)) return;
    f32x4 acc[2][2][4][2];
#pragma unroll
    for (int a = 0; a < 2; ++a)
#pragma unroll
        for (int b = 0; b < 2; ++b)
#pragma unroll
            for (int m = 0; m < 4; ++m)
#pragma unroll
                for (int n = 0; n < 2; ++n) acc[a][b][m][n] = (f32x4){0.f, 0.f, 0.f, 0.f};
    bf16x8 At[4][2], B0[2][2], B1[2][2];
    const char* cA = (const char*)g.A + (size_t)cur.pm * tstep; const char* cB = (const char*)g.Bt + (size_t)cur.pn * tstep;
    S.a_ready(cur);
    if constexpr (SP2) {
        PG8_STAGE(PG8_SB(0, 0), cB, voffB); PG8_STAGE(PG8_SB(0, 1), cB + hstep, voffB); PG8_STAGE(PG8_SA(0, 0), cA, voffA); PG8_STAGE(PG8_SA(0, 1), cA + hstep, voffA);
        if (wr == 1) PG8_BAR;
        PG8_WAIT_V(2); PG8_BAR;
        PG8_STAGE(PG8_SB(1, 0), cB + kstep, voffB); PG8_STAGE(PG8_SA(1, 0), cA + kstep, voffA); PG8_STAGE(PG8_SB(1, 1), cB + hstep + kstep, voffB);
        PG8_WAIT_V(6); PG8_BAR;
    } else {
        PG8_STAGE(PG8_SB(0, 0), cB, voffB); PG8_STAGE(PG8_SA(0, 0), cA, voffA); PG8_STAGE(PG8_SB(0, 1), cB + hstep, voffB); PG8_STAGE(PG8_SA(0, 1), cA + hstep, voffA);
        if (wr == 1) PG8_BAR;
        PG8_WAIT_V(4); PG8_BAR;
        PG8_STAGE(PG8_SB(1, 0), cB + kstep, voffB); PG8_STAGE(PG8_SA(1, 0), cA + kstep, voffA); PG8_STAGE(PG8_SB(1, 1), cB + hstep + kstep, voffB);
        PG8_WAIT_V(6); PG8_BAR;
    }
    for (;;) {
        const bool has_next = S.next(ui + 1, nxt);
        const char* nA = has_next ? (const char*)g.A + (size_t)nxt.pm * tstep : cA; const char* nB = has_next ? (const char*)g.Bt + (size_t)nxt.pn * tstep : cB;
        for (int t = 0; t < nt; t += 2) {
            const bool last = (t == nt - 2);
            const char* a1 = cA + (size_t)(t + 1) * kstep;
            const char* a2 = last ? nA : cA + (size_t)(t + 2) * kstep; const char* b2 = last ? nB : cB + (size_t)(t + 2) * kstep;
            const char* a3 = a2 + kstep; const char* b3 = b2 + kstep;
            if (last && has_next) S.a_ready(nxt);
            if constexpr (SP2) {
            PG8_LDB(B0, 0, 0); PG8_LDB(B1, 0, 1); PG8_SCHED; PG8_LDA(At, 0, 0); PG8_STAGE(PG8_SA(1, 1), a1 + hstep, voffA);
            PG8_WAIT_V(8); PG8_WAIT_L(0); PG8_BAR; PG8_MMA(0, 0, At, B0); PG8_MMA(0, 1, At, B1); PG8_BAR; PG8_SCHED;
            PG8_LDA(At, 0, 1); PG8_STAGE(PG8_SB(0, 0), b2, voffB); PG8_STAGE(PG8_SB(0, 1), b2 + hstep, voffB); PG8_STAGE(PG8_SA(0, 0), a2, voffA);
            PG8_WAIT_V(8); PG8_WAIT_L(0); PG8_BAR; PG8_MMA(1, 0, At, B0); PG8_MMA(1, 1, At, B1); PG8_BAR; PG8_SCHED;
            PG8_LDB(B0, 1, 0); PG8_LDB(B1, 1, 1); PG8_SCHED; PG8_LDA(At, 1, 0); PG8_STAGE(PG8_SA(0, 1), a2 + hstep, voffA);
            PG8_WAIT_V(8); PG8_WAIT_L(0); PG8_BAR; PG8_MMA(0, 0, At, B0); PG8_MMA(0, 1, At, B1); PG8_BAR; PG8_SCHED;
            PG8_LDA(At, 1, 1); PG8_STAGE(PG8_SB(1, 0), b3, voffB); PG8_STAGE(PG8_SB(1, 1), b3 + hstep, voffB); PG8_STAGE(PG8_SA(1, 0), a3, voffA);
            PG8_WAIT_V(8); PG8_WAIT_L(0); PG8_BAR; PG8_MMA(1, 0, At, B0); PG8_MMA(1, 1, At, B1); PG8_BAR; PG8_SCHED;
            } else {
            PG8_LDB(B0, 0, 0); PG8_SCHED; PG8_LDA(At, 0, 0); PG8_STAGE(PG8_SA(1, 1), a1 + hstep, voffA);
            PG8_WAIT_L(8); PG8_BAR; PG8_WAIT_L(0); PG8_MMA(0, 0, At, B0); PG8_BAR; PG8_SCHED;
            PG8_LDB(B1, 0, 1); PG8_STAGE(PG8_SB(0, 0), b2, voffB);
            PG8_BAR; PG8_WAIT_L(0); PG8_MMA(0, 1, At, B1); PG8_BAR;
            PG8_LDA(At, 0, 1); PG8_STAGE(PG8_SA(0, 0), a2, voffA);
            PG8_BAR; PG8_WAIT_L(0); PG8_MMA(1, 0, At, B0); PG8_BAR; PG8_SCHED;
            PG8_STAGE(PG8_SB(0, 1), b2 + hstep, voffB);
            PG8_WAIT_V(6); PG8_BAR; PG8_MMA(1, 1, At, B1); PG8_BAR;
            PG8_LDB(B0, 1, 0); PG8_SCHED; PG8_LDA(At, 1, 0); PG8_STAGE(PG8_SA(0, 1), a2 + hstep, voffA);
            PG8_WAIT_L(8); PG8_BAR; PG8_WAIT_L(0); PG8_MMA(0, 0, At, B0); PG8_BAR; PG8_SCHED;
            PG8_LDB(B1, 1, 1); PG8_STAGE(PG8_SB(1, 0), b3, voffB);
            PG8_BAR; PG8_WAIT_L(0); PG8_MMA(0, 1, At, B1); PG8_BAR;
            PG8_LDA(At, 1, 1); PG8_STAGE(PG8_SA(1, 0), a3, voffA);
            PG8_BAR; PG8_WAIT_L(0); PG8_MMA(1, 0, At, B0); PG8_BAR; PG8_SCHED;
            PG8_STAGE(PG8_SB(1, 1), b3 + hstep, voffB);
            PG8_WAIT_V(6); PG8_BAR; PG8_MMA(1, 1, At, B1); PG8_BAR;
            }
        }
        if constexpr (ALIGN_EPI) { if (wr == 0) PG8_BAR; }
        if constexpr (!Epi::AFTER_DRAIN) { E(acc, cur, wr, wc, fr, fq); S.done(cur); }
        if (!has_next) break;
#pragma unroll
        for (int a = 0; a < 2; ++a)
#pragma unroll
            for (int b = 0; b < 2; ++b)
#pragma unroll
                for (int m = 0; m < 4; ++m)
#pragma unroll
                    for (int n = 0; n < 2; ++n) acc[a][b][m][n] = (f32x4){0.f, 0.f, 0.f, 0.f};
        cur = nxt; cA = nA; cB = nB; ++ui;
        if constexpr (ALIGN_EPI) { if (wr == 1) PG8_BAR; }
    }
    PG8_WAIT_V(0);
    if constexpr (!ALIGN_EPI) { if (wr == 0) PG8_BAR; }
    PG8_BAR;
    if constexpr (Epi::AFTER_DRAIN) { E.fused(acc, cur, wr, wc, fr, fq, lds, wid, lane); S.done(cur); }
#undef PG8_SA
#undef PG8_SB
#undef PG8_STAGE
#undef PG8_LDA
#undef PG8_LDB
#undef PG8_MMA
#undef PG8_WAIT_V
#undef PG8_WAIT_L
#undef PG8_BAR
#undef PG8_SCHED
}
}

#ifndef PG8_SP2
#define PG8_SP2 true
#endif
#ifndef PG8_ALIGN
#define PG8_ALIGN true
#endif
#ifndef MK_SPLIT
#define MK_SPLIT 0
#endif

constexpr int SEQ = 8192, DM = 2048, DFF = 5632, CW = 1024, AW = 1024, NH = 8, INW = 5120, NMOD = 9, CK = 31;
constexpr int NMODW = NMOD * DM;
constexpr int KSPLIT = 16;
constexpr float EPS = 1e-6f;
constexpr float LOG2E = 1.4426950408889634f;
constexpr float QSCALE = 0.125f * LOG2E;
constexpr int NPHASE = 12;

constexpr size_t MiB = 1u << 20;
constexpr size_t WS_MODP = 1 * MiB;
constexpr size_t WS_WGU1 = 4 * MiB, WS_WD1 = 48 * MiB, WS_WIN = 70 * MiB, WS_WOUT = 90 * MiB, WS_WGU2 = 98 * MiB, WS_WD2 = 142 * MiB;
constexpr size_t WS_H = 164 * MiB, WS_ACT = 196 * MiB;
constexpr size_t WS_VG = WS_ACT, WS_Q = WS_ACT + 16 * MiB, WS_K = WS_ACT + 32 * MiB, WS_VT = WS_ACT + 48 * MiB, WS_YCAT = WS_ACT + 64 * MiB;
constexpr size_t WS_Y = 292 * MiB, WS_X1 = 356 * MiB, WS_PART = 420 * MiB, WS_END = 440 * MiB;
constexpr int PART_FLOATS = 32768 + 1024;

constexpr int LDS_BYTES = 147456;

#define LAS __attribute__((address_space(3)))
typedef unsigned short bf16_t;
typedef float f32x4 __attribute__((ext_vector_type(4)));
typedef float f32x16 __attribute__((ext_vector_type(16)));
typedef unsigned u32x4 __attribute__((ext_vector_type(4)));
typedef unsigned u32x2 __attribute__((ext_vector_type(2)));
typedef short bf16x8 __attribute__((ext_vector_type(8)));

__device__ __forceinline__ unsigned f2bf(float f) { unsigned u = __builtin_bit_cast(unsigned, f); return (u + 0x7fffu + ((u >> 16) & 1u)) >> 16; }
__device__ __forceinline__ unsigned pk2(float lo, float hi) { return pg8::cvt_pk_bf16(lo, hi); }
__device__ __forceinline__ float bflo(unsigned u) { return __builtin_bit_cast(float, u << 16); }
__device__ __forceinline__ float bfhi(unsigned u) { return __builtin_bit_cast(float, u & 0xffff0000u); }
__device__ __forceinline__ float sigm(float x) { return __builtin_amdgcn_rcpf(1.f + __builtin_amdgcn_exp2f(-LOG2E * x)); }
__device__ __forceinline__ float wave_sum(float v) {
#pragma unroll
    for (int o = 1; o < 64; o <<= 1) v += __shfl_xor(v, o);
    return v;
}

struct EpiSwiGLU {
    static constexpr bool PERM = true, AFTER_DRAIN = false;
    bf16_t* O; int ldo;
    __device__ __forceinline__ void operator()(const pg8::f32x4 (&acc)[2][2][4][2], const pg8::Unit& u, int wr, int wc, int fr, int fq) const {
        const int row0 = u.pm * 256 + wr * 64 + fr, col0 = u.pn * 128 + wc * 32 + 8 * fq;
#pragma unroll
        for (int ai = 0; ai < 2; ++ai)
#pragma unroll
            for (int m = 0; m < 4; ++m) {
                bf16_t* rowp = O + (size_t)(row0 + ai * 128 + m * 16) * ldo + col0;
                float v[8];
#pragma unroll
                for (int n = 0; n < 2; ++n)
#pragma unroll
                    for (int i = 0; i < 4; ++i) { const float g = acc[ai][0][m][n][i], up = acc[ai][1][m][n][i]; v[n * 4 + i] = g * sigm(g) * up; }
                u32x4 w; w.x = pk2(v[0], v[1]); w.y = pk2(v[2], v[3]); w.z = pk2(v[4], v[5]); w.w = pk2(v[6], v[7]);
                *(u32x4*)rowp = w;
            }
    }
};
struct EpiInProj {
    static constexpr bool PERM = true, AFTER_DRAIN = false;
    bf16_t* VG; bf16_t* Q; bf16_t* K; const float* b_in; unsigned* kmax2c;
    __device__ __forceinline__ void operator()(const pg8::f32x4 (&acc)[2][2][4][2], const pg8::Unit& u, int wr, int wc, int fr, int fq) const {
        const int row0 = u.pm * 256 + wr * 64 + fr;
        if (u.pn < 8) {
            const int col0 = u.pn * 128 + wc * 32 + 8 * fq;
            f32x4 ba[2], bg[2];
#pragma unroll
            for (int n = 0; n < 2; ++n) { ba[n] = *(const f32x4*)(b_in + col0 + 4 * n); bg[n] = *(const f32x4*)(b_in + CW + col0 + 4 * n); }
#pragma unroll
            for (int ai = 0; ai < 2; ++ai)
#pragma unroll
                for (int m = 0; m < 4; ++m) {
                    bf16_t* rowp = VG + (size_t)(row0 + ai * 128 + m * 16) * CW + col0;
                    float v[8];
#pragma unroll
                    for (int n = 0; n < 2; ++n)
#pragma unroll
                        for (int i = 0; i < 4; ++i) { const float a = acc[ai][0][m][n][i] + ba[n][i], g = acc[ai][1][m][n][i] + bg[n][i]; v[n * 4 + i] = a * sigm(g); }
                    u32x4 w; w.x = pk2(v[0], v[1]); w.y = pk2(v[2], v[3]); w.z = pk2(v[4], v[5]); w.w = pk2(v[6], v[7]);
                    *(u32x4*)rowp = w;
                }
        } else {
            const int t = (u.pn - 8) >> 2; bf16_t* base = t ? K : Q; const float sc = t ? 1.f : QSCALE;
            const int col0 = ((u.pn - 8) & 3) * 256 + wc * 32 + 8 * fq;
            float cm[2] = {0.f, 0.f};
#pragma unroll
            for (int ai = 0; ai < 2; ++ai)
#pragma unroll
                for (int m = 0; m < 4; ++m) {
                    bf16_t* rowp = base + (size_t)(row0 + ai * 128 + m * 16) * AW + col0;
#pragma unroll
                    for (int bj = 0; bj < 2; ++bj) {
                        const pg8::f32x4 v0 = acc[ai][bj][m][0] * sc, v1 = acc[ai][bj][m][1] * sc;
                        u32x4 w; w.x = pk2(v0[0], v0[1]); w.y = pk2(v0[2], v0[3]); w.z = pk2(v1[0], v1[1]); w.w = pk2(v1[2], v1[3]);
                        *(u32x4*)(rowp + bj * 128) = w;
                        if (t) { const float a0 = bflo(w.x), a1 = bfhi(w.x), a2 = bflo(w.y), a3 = bfhi(w.y), a4 = bflo(w.z), a5 = bfhi(w.z), a6 = bflo(w.w), a7 = bfhi(w.w);
                            cm[bj] = __builtin_fmaxf(cm[bj], ((a0 * a0 + a1 * a1) + (a2 * a2 + a3 * a3)) + ((a4 * a4 + a5 * a5) + (a6 * a6 + a7 * a7))); }
                    }
                }
            if (t) {
#pragma unroll
                for (int bj = 0; bj < 2; ++bj) { float v = cm[bj];
#pragma unroll
                    for (int x = 1; x < 16; x <<= 1) v = __builtin_fmaxf(v, __shfl_xor(v, x));
                    const int col = col0 + bj * 128;
                    if (fr == 0) atomicMax(kmax2c + (col >> 6) * 8 + ((col & 63) >> 3), __builtin_bit_cast(unsigned, v)); }
            }
        }
    }
};
struct EpiBf16Plain {
    static constexpr bool PERM = true, AFTER_DRAIN = false;
    bf16_t* O; int ldo;
    __device__ __forceinline__ void operator()(const pg8::f32x4 (&acc)[2][2][4][2], const pg8::Unit& u, int wr, int wc, int fr, int fq) const {
        const int row0 = u.pm * 256 + wr * 64 + fr, col0 = u.pn * 256 + wc * 32 + 8 * fq;
#pragma unroll
        for (int ai = 0; ai < 2; ++ai)
#pragma unroll
            for (int m = 0; m < 4; ++m) {
                bf16_t* rowp = O + (size_t)(row0 + ai * 128 + m * 16) * ldo + col0;
#pragma unroll
                for (int bj = 0; bj < 2; ++bj) {
                    const pg8::f32x4 v0 = acc[ai][bj][m][0], v1 = acc[ai][bj][m][1];
                    u32x4 w; w.x = pk2(v0[0], v0[1]); w.y = pk2(v0[2], v0[3]); w.z = pk2(v1[0], v1[1]); w.w = pk2(v1[2], v1[3]);
                    *(u32x4*)(rowp + bj * 128) = w;
                }
            }
    }
};
struct EpiF32 {
    static constexpr bool PERM = true, AFTER_DRAIN = false;
    float* O; int ldo;
    __device__ __forceinline__ void operator()(const pg8::f32x4 (&acc)[2][2][4][2], const pg8::Unit& u, int wr, int wc, int fr, int fq) const {
        const int row0 = u.pm * 256 + wr * 64 + fr, col0 = u.pn * 256 + wc * 32 + 8 * fq;
#pragma unroll
        for (int ai = 0; ai < 2; ++ai)
#pragma unroll
            for (int m = 0; m < 4; ++m) {
                float* rowp = O + (size_t)(row0 + ai * 128 + m * 16) * ldo + col0;
#pragma unroll
                for (int bj = 0; bj < 2; ++bj) { *(pg8::f32x4*)(rowp + bj * 128) = acc[ai][bj][m][0]; *(pg8::f32x4*)(rowp + bj * 128 + 4) = acc[ai][bj][m][1]; }
            }
    }
};

struct TrItem { const float* src; bf16_t* dst; int ld, K; bool nt; };
__device__ __forceinline__ void tr_load(const TrItem& t, float (&v)[32], int lane) {
    const float* wp = t.src + (size_t)(lane >> 5) * t.ld + (lane & 31);
#pragma unroll
    for (int i = 0; i < 32; ++i) v[i] = __builtin_nontemporal_load(wp + (size_t)(2 * i) * t.ld);
}
__device__ __forceinline__ void tr_finish(const TrItem& t, const float (&v)[32], LAS float* scr, int lane) {
#pragma unroll
    for (int i = 0; i < 32; ++i) scr[(2 * i + (lane >> 5)) * 33 + (lane & 31)] = v[i];
    asm volatile("s_waitcnt lgkmcnt(0)" ::: "memory");
    const int c = lane & 7;
#pragma unroll
    for (int j = 0; j < 4; ++j) { const int n = (lane >> 3) + 8 * j; const LAS float* s = scr + (8 * c) * 33 + n;
        u32x4 o; o.x = pk2(s[0 * 33], s[1 * 33]); o.y = pk2(s[2 * 33], s[3 * 33]); o.z = pk2(s[4 * 33], s[5 * 33]); o.w = pk2(s[6 * 33], s[7 * 33]);
        u32x4* dp = (u32x4*)(t.dst + (size_t)n * t.K + 8 * c); if (t.nt) __builtin_nontemporal_store(o, dp); else *dp = o; }
    asm volatile("s_waitcnt lgkmcnt(0)" ::: "memory");
}
__device__ __forceinline__ TrItem mk_item(const float* W, int ld, int srccol0, int k0, bf16_t* WT, int K, int destrow0) {
    TrItem t; t.src = W + (size_t)k0 * ld + srccol0; t.dst = WT + (size_t)destrow0 * K + k0; t.ld = ld; t.K = K; t.nt = false; return t;
}
__device__ __forceinline__ TrItem it_gu(const float* wg, const float* wu, bf16_t* WT, int r) {
    constexpr int nblk = 2 * DFF / 32; const int kb = r / nblk, nb = r % nblk, R0 = 32 * nb, pn = R0 >> 8, bj = (R0 >> 7) & 1, j0 = R0 & 127;
    return mk_item(bj ? wu : wg, DFF, 128 * pn + j0, 64 * kb, WT, DM, R0);
}
__device__ __forceinline__ TrItem it_plain(const float* w, int K, int N, bf16_t* WT, int r) {
    const int nblk = N / 32, kb = r / nblk, nb = r % nblk;
    return mk_item(w, N, 32 * nb, 64 * kb, WT, K, 32 * nb);
}
__device__ __forceinline__ TrItem it_in(const float* w, bf16_t* WT, int r) {
    constexpr int nblk = INW / 32; const int kb = r / nblk, nb = r % nblk, R0 = 32 * nb;
    int src = R0;
    if (R0 < 2 * CW) { const int pn = R0 >> 8, bj = (R0 >> 7) & 1, j0 = R0 & 127; src = bj * CW + 128 * pn + j0; }
    return mk_item(w, INW, src, 64 * kb, WT, DM, R0);
}
constexpr int I_GU = (DM / 64) * (2 * DFF / 32), I_D = (DFF / 64) * (DM / 32), I_IN = (DM / 64) * (INW / 32), I_O = (DM / 64) * (DM / 32);
constexpr int NITEMS_A = 2 * I_GU + I_D + I_IN, NITEMS_B = I_O + I_D;
struct WPtrs { const float *w1g, *w1u, *w1d, *win, *wout, *w2g, *w2u, *w2d; bf16_t *Wgu1, *Wd1, *Win, *Wout, *Wgu2, *Wd2; };
__device__ __forceinline__ TrItem item_a(const WPtrs& P, int r) {
    if (r < I_GU) return it_gu(P.w1g, P.w1u, P.Wgu1, r); r -= I_GU;
    if (r < I_D) return it_plain(P.w1d, DFF, DM, P.Wd1, r); r -= I_D;
    if (r < I_IN) { TrItem t = it_in(P.win, P.Win, r); t.nt = true; return t; } r -= I_IN;
    TrItem t = it_gu(P.w2g, P.w2u, P.Wgu2, r); t.nt = true; return t;
}
__device__ __forceinline__ TrItem item_b(const WPtrs& P, int r) {
    TrItem t = (r < I_O) ? it_plain(P.wout, DM, DM, P.Wout, r) : it_plain(P.w2d, DFF, DM, P.Wd2, r - I_O); t.nt = true; return t;
}
template <bool LIST_B> __device__ __forceinline__ void tr_run(const WPtrs& P, int first, int stride, LAS float* scr, int lane, int lo = 0, int hi = (LIST_B ? NITEMS_B : NITEMS_A)) {
    if (lo + first >= hi) return;
    float va[32];
    for (int it = lo + first; it < hi; it += stride) { const TrItem ta = LIST_B ? item_b(P, it) : item_a(P, it); tr_load(ta, va, lane); tr_finish(ta, va, scr, lane); }
}

__device__ __forceinline__ f32x4 mod4(const float* modp, const float* b_ada, int idx) {
    f32x4 a = *(const f32x4*)(b_ada + idx);
#pragma unroll
    for (int s = 0; s < KSPLIT; ++s) a += *(const f32x4*)(modp + (size_t)s * NMODW + idx);
    return a;
}

template <bool HAS_Y, bool HAS_H, bool FULLMOD, bool RES_BF16 = false, bool OUT_BF16 = false>
__device__ __forceinline__ void row_phase(LAS unsigned char* lds, int gw, int NGW, int tid, int lane,
                                          const bf16_t* Y, const float* resid, float* xout, bf16_t* H,
                                          const float* modp, const float* b_ada, const float* g_post, int gate_idx, float coef,
                                          const float* g_pre, int sh_idx, int sc_idx) {
    LAS f32x4* G1 = (LAS f32x4*)lds; LAS f32x4* G2 = (LAS f32x4*)(lds + 8192); LAS f32x4* SH = (LAS f32x4*)(lds + 16384);
    {
        const int c = tid * 4;
        if (HAS_Y) { const f32x4 gt = FULLMOD ? *(const f32x4*)(modp + gate_idx * DM + c) : mod4(modp, b_ada, gate_idx * DM + c); G1[tid] = gt * *(const f32x4*)(g_post + c) * coef; }
        if (HAS_H) { const f32x4 sc = FULLMOD ? *(const f32x4*)(modp + sc_idx * DM + c) : mod4(modp, b_ada, sc_idx * DM + c);
                     G2[tid] = *(const f32x4*)(g_pre + c) * (sc + 1.f); SH[tid] = FULLMOD ? *(const f32x4*)(modp + sh_idx * DM + c) : mod4(modp, b_ada, sh_idx * DM + c); }
    }
    __syncthreads();
    for (int row = gw; row < SEQ; row += NGW) {
        f32x4 xv[8];
        const f32x4* rp = (const f32x4*)(resid + (size_t)row * DM) + lane;
        if (HAS_Y) {
            const u32x2* yp = (const u32x2*)(Y + (size_t)row * DM) + lane;
            f32x4 yv[8]; float ss = 0.f; u32x2 yr[8];
#pragma unroll
            for (int j = 0; j < 8; ++j) { yr[j] = yp[64 * j];
                if (RES_BF16) { const u32x2 t = ((const u32x2*)((const bf16_t*)resid + (size_t)row * DM) + lane)[64 * j]; xv[j] = (f32x4){bflo(t.x), bfhi(t.x), bflo(t.y), bfhi(t.y)}; }
                else xv[j] = __builtin_nontemporal_load(rp + 64 * j); }
#pragma unroll
            for (int j = 0; j < 8; ++j) yv[j] = (f32x4){bflo(yr[j].x), bfhi(yr[j].x), bflo(yr[j].y), bfhi(yr[j].y)};
#pragma unroll
            for (int j = 0; j < 8; ++j) ss += (yv[j].x * yv[j].x + yv[j].y * yv[j].y) + (yv[j].z * yv[j].z + yv[j].w * yv[j].w);
            const float r = __builtin_amdgcn_rsqf(wave_sum(ss) * (1.f / DM) + EPS);
            f32x4* op = (f32x4*)(xout + (size_t)row * DM) + lane;
#pragma unroll
            for (int j = 0; j < 8; ++j) { xv[j] = xv[j] + G1[lane + 64 * j] * (yv[j] * r);
                if (OUT_BF16) { u32x2 w; w.x = pk2(xv[j].x, xv[j].y); w.y = pk2(xv[j].z, xv[j].w); ((u32x2*)((bf16_t*)xout + (size_t)row * DM) + lane)[64 * j] = w; }
                else if (HAS_H) op[64 * j] = xv[j]; else __builtin_nontemporal_store(xv[j], op + 64 * j); }
        } else {
#pragma unroll
            for (int j = 0; j < 8; ++j) xv[j] = __builtin_nontemporal_load(rp + 64 * j);
        }
        if (HAS_H) {
            float ss = 0.f;
#pragma unroll
            for (int j = 0; j < 8; ++j) ss += (xv[j].x * xv[j].x + xv[j].y * xv[j].y) + (xv[j].z * xv[j].z + xv[j].w * xv[j].w);
            const float r = __builtin_amdgcn_rsqf(wave_sum(ss) * (1.f / DM) + EPS);
            u32x2* hp = (u32x2*)(H + (size_t)row * DM) + lane;
#pragma unroll
            for (int j = 0; j < 8; ++j) { const f32x4 hv = (xv[j] * r) * G2[lane + 64 * j] + SH[lane + 64 * j]; u32x2 w; w.x = pk2(hv.x, hv.y); w.y = pk2(hv.z, hv.w); hp[64 * j] = w; }
        }
    }
    __syncthreads();
}

__device__ __forceinline__ void conv_unit(LAS unsigned char* lds, int s0, const bf16_t* VG, const float* w_dw, const float* b_dw, const float* ln_g, const float* ln_b,
                                          bf16_t* YC, int tid, int wid, int lane) {
    for (int p = tid; p < 62 * 128; p += 512) { const int i = p >> 7, c = p & 127, srow = s0 - 30 + i;
        u32x4 v = (u32x4){0u, 0u, 0u, 0u}; if (srow >= 0) v = *(const u32x4*)(VG + (size_t)srow * CW + c * 8);
        *(LAS u32x4*)(lds + i * 2048 + c * 16) = v; }
    __syncthreads();
    float acc[4][16];
#pragma unroll
    for (int r = 0; r < 4; ++r)
#pragma unroll
        for (int i = 0; i < 16; ++i) acc[r][i] = 0.f;
#pragma unroll 4
    for (int j = 0; j < CK; ++j) {
        const float* wp = w_dw + j * CW + lane * 8;
        const f32x4 w0 = *(const f32x4*)wp, w1 = *(const f32x4*)(wp + 4), w2 = *(const f32x4*)(wp + 512), w3 = *(const f32x4*)(wp + 516);
        const float w[16] = {w0.x, w0.y, w0.z, w0.w, w1.x, w1.y, w1.z, w1.w, w2.x, w2.y, w2.z, w2.w, w3.x, w3.y, w3.z, w3.w};
#pragma unroll
        for (int r = 0; r < 4; ++r) {
            const LAS unsigned char* rowp = lds + (wid * 4 + r + j) * 2048 + lane * 16;
            const u32x4 a = *(const LAS u32x4*)rowp, b = *(const LAS u32x4*)(rowp + 1024);
            const float in[16] = {bflo(a.x), bfhi(a.x), bflo(a.y), bfhi(a.y), bflo(a.z), bfhi(a.z), bflo(a.w), bfhi(a.w),
                                  bflo(b.x), bfhi(b.x), bflo(b.y), bfhi(b.y), bflo(b.z), bfhi(b.z), bflo(b.w), bfhi(b.w)};
#pragma unroll
            for (int i = 0; i < 16; ++i) acc[r][i] += w[i] * in[i];
        }
    }
    {
        const float* bp = b_dw + lane * 8; const float* gp = ln_g + lane * 8; const float* lp = ln_b + lane * 8;
        const f32x4 b0 = *(const f32x4*)bp, b1 = *(const f32x4*)(bp + 4), b2 = *(const f32x4*)(bp + 512), b3 = *(const f32x4*)(bp + 516);
        const f32x4 g0 = *(const f32x4*)gp, g1 = *(const f32x4*)(gp + 4), g2 = *(const f32x4*)(gp + 512), g3 = *(const f32x4*)(gp + 516);
        const f32x4 l0 = *(const f32x4*)lp, l1 = *(const f32x4*)(lp + 4), l2 = *(const f32x4*)(lp + 512), l3 = *(const f32x4*)(lp + 516);
        const float bb[16] = {b0.x, b0.y, b0.z, b0.w, b1.x, b1.y, b1.z, b1.w, b2.x, b2.y, b2.z, b2.w, b3.x, b3.y, b3.z, b3.w};
        const float gg[16] = {g0.x, g0.y, g0.z, g0.w, g1.x, g1.y, g1.z, g1.w, g2.x, g2.y, g2.z, g2.w, g3.x, g3.y, g3.z, g3.w};
        const float ll[16] = {l0.x, l0.y, l0.z, l0.w, l1.x, l1.y, l1.z, l1.w, l2.x, l2.y, l2.z, l2.w, l3.x, l3.y, l3.z, l3.w};
#pragma unroll
        for (int r = 0; r < 4; ++r) {
            float s = 0.f;
#pragma unroll
            for (int i = 0; i < 16; ++i) { acc[r][i] += bb[i]; s += acc[r][i]; }
            const float mu = wave_sum(s) * (1.f / CW); float q = 0.f;
#pragma unroll
            for (int i = 0; i < 16; ++i) { acc[r][i] -= mu; q += acc[r][i] * acc[r][i]; }
            const float rstd = __builtin_amdgcn_rsqf(wave_sum(q) * (1.f / CW) + EPS);
            float o[16];
#pragma unroll
            for (int i = 0; i < 16; ++i) { const float y = acc[r][i] * rstd * gg[i] + ll[i]; o[i] = y * sigm(y); }
            bf16_t* op = YC + (size_t)(s0 + wid * 4 + r) * DM + lane * 8;
            u32x4 wa; wa.x = pk2(o[0], o[1]); wa.y = pk2(o[2], o[3]); wa.z = pk2(o[4], o[5]); wa.w = pk2(o[6], o[7]);
            u32x4 wb; wb.x = pk2(o[8], o[9]); wb.y = pk2(o[10], o[11]); wb.z = pk2(o[12], o[13]); wb.w = pk2(o[14], o[15]);
            *(u32x4*)op = wa; *(u32x4*)(op + 512) = wb;
        }
    }
    __syncthreads();
}

constexpr int SCHED_W = 3, SCHED_NSLOT = 69;
__device__ const unsigned short SCHED[256][SCHED_W] = {{350,191,65535},
{414,135,65535},
{478,190,65535},
{284,172,65535},
{285,199,65535},
{360,65535,65535},
{424,65535,65535},
{488,65535,65535},
{283,330,65535},
{411,163,65535},
{949,160,65535},
{164,1462,65535},
{286,263,65535},
{359,65535,65535},
{423,65535,65535},
{487,65535,65535},
{475,165,65535},
{1013,166,65535},
{161,1526,65535},
{147,57,1456},
{287,156,65535},
{358,65535,65535},
{422,65535,65535},
{486,65535,65535},
{892,325,51},
{948,106,58},
{107,59,1461},
{1012,108,60},
{288,158,65535},
{357,0,65535},
{421,256,65535},
{485,128,65535},
{109,52,1525},
{282,389,61},
{346,453,62},
{344,153,63},
{289,200,65535},
{356,322,65535},
{420,386,65535},
{484,450,65535},
{879,154,53},
{408,155,66},
{943,145,2},
{947,134,130},
{884,133,258},
{355,5,65535},
{419,387,65535},
{483,451,65535},
{157,54,1392},
{474,198,194},
{1011,146,129},
{159,1,1524},
{291,197,257},
{354,195,65535},
{418,259,65535},
{482,323,65535},
{882,458,65535},
{265,1395,65535},
{894,329,65535},
{946,201,65535},
{292,261,193},
{353,67,65535},
{417,131,65535},
{481,452,65535},
{393,1459,65535},
{1010,457,65535},
{264,65,1523},
{281,262,11},
{293,68,12},
{352,123,65535},
{416,124,65535},
{480,125,65535},
{345,326,6},
{881,390,13},
{454,14,1394},
{895,137,15},
{294,69,16},
{126,1407,65535},
{959,127,65535},
{1023,132,65535},
{409,138,3},
{945,139,17},
{136,18,1458},
{473,140,19},
{295,70,20},
{351,110,65535},
{958,196,65535},
{1022,260,65535},
{1009,141,4},
{142,21,1522},
{880,397,65535},
{461,1393,65535},
{296,71,22},
{111,1406,65535},
{324,1471,65535},
{388,1535,65535},
{944,268,65535},
{332,1457,65535},
{1008,396,65535},
{204,1521,65535},
{297,72,23},
{112,1405,65535},
{415,113,65535},
{479,114,65535},
{280,460,65535},
{883,267,65535},
{331,1396,65535},
{203,1460,65535},
{298,73,24},
{317,97,8},
{957,115,65535},
{1021,116,65535},
{893,395,65535},
{410,459,65535},
{266,1397,65535},
{472,202,192},
{299,74,25},
{98,321,1404},
{117,1470,65535},
{118,1534,65535},
{1007,162,55},
{394,64,1520},
{878,252,65535},
{248,1391,65535},
{300,75,26},
{99,320,1403},
{956,119,65535},
{1020,120,65535},
{942,253,65535},
{254,1455,65535},
{1006,255,65535},
{249,1519,65535},
{301,76,27},
{349,327,65535},
{121,1469,65535},
{122,1533,65535},
{279,206,65535},
{343,270,65535},
{877,334,65535},
{250,1390,65535},
{302,77,28},
{328,1402,65535},
{318,100,9},
{319,101,10},
{407,398,65535},
{941,462,65535},
{205,1454,65535},
{471,251,65535},
{303,78,29},
{888,148,65535},
{955,102,385},
{1019,103,449},
{1005,269,65535},
{333,1518,65535},
{876,236,65535},
{232,1389,65535},
{304,79,30},
{80,31,1401},
{104,384,1468},
{105,448,1532},
{940,237,65535},
{238,1453,65535},
{1004,239,65535},
{233,1517,65535},
{305,81,32},
{348,173,65535},
{954,149,65535},
{1018,143,65535},
{278,240,65535},
{342,241,65535},
{875,242,65535},
{234,1388,65535},
{306,82,33},
{887,174,65535},
{150,1467,65535},
{151,1531,65535},
{406,243,65535},
{939,244,65535},
{245,1452,65535},
{470,235,65535},
{307,83,34},
{175,1400,65535},
{413,391,65535},
{477,455,65535},
{1003,246,65535},
{247,1516,65535},
{874,220,65535},
{216,1387,65535},
{308,84,35},
{889,176,65535},
{953,392,65535},
{1017,456,65535},
{938,221,65535},
{222,1451,65535},
{1002,223,65535},
{217,1515,65535},
{309,85,36},
{886,177,65535},
{152,1466,65535},
{144,1530,65535},
{277,224,65535},
{341,225,65535},
{873,226,65535},
{218,1386,65535},
{310,86,37},
{178,1399,65535},
{952,87,38},
{1016,88,39},
{405,227,65535},
{937,228,65535},
{229,1450,65535},
{469,219,65535},
{311,89,40},
{890,179,65535},
{90,41,1465},
{91,42,1529},
{1001,230,65535},
{231,1514,65535},
{211,1385,65535},
{209,1449,65535},
{312,92,43},
{347,167,65535},
{412,180,65535},
{476,181,65535},
{212,1513,65535},
{276,213,65535},
{340,214,65535},
{404,210,65535},
{313,93,44},
{885,168,65535},
{951,182,65535},
{1015,183,65535},
{468,215,65535},
{275,466,65535},
{339,401,65535},
{403,337,65535},
{314,94,45},
{169,1398,65535},
{184,1464,65535},
{185,1528,65535},
{400,208,56},
{467,274,65535},
{338,402,65535},
{464,271,46},
{315,95,47},
{891,170,65535},
{950,186,65535},
{1014,187,65535},
{399,335,7},
{273,465,65535},
{272,207,48},
{336,463,49},
{316,96,50},
{290,171,65535},
{188,1463,65535},
{189,1527,65535}};
constexpr int SPLIT_H0 = 5, SPLIT_QB0 = 41, SPLIT_NQ = 23;
__device__ __forceinline__ int crow(int r, int hi) { return (r & 3) + 8 * (r >> 2) + 4 * hi; }
#define MFMA32(a, b, c) __builtin_amdgcn_mfma_f32_32x32x16_bf16((a), (b), (c), 0, 0, 0)
constexpr int ATT_KCH = 1040, ATT_VCH = 2064, ATT_VOFF = 16 * ATT_KCH, ATT_STAGE = 33280, ATT_QOFF = 2 * ATT_STAGE, ATT_QCH = 2064, ATT_EX = 0, MISC_OFF = 134144;
static_assert(ATT_VOFF + 8 * ATT_VCH <= ATT_STAGE && ATT_QOFF + 16 * ATT_QCH <= 131072 && 65536 <= ATT_QOFF && MISC_OFF + 64 <= LDS_BYTES && MISC_OFF >= 131072, "LDS map");
__device__ __forceinline__ void attn_unit(LAS unsigned char* lds, int type, int h, int qb, const bf16_t* Q, const bf16_t* Kg, const bf16_t* VT, bf16_t* YC,
                                          const float* subln_g, float lam, const unsigned* kmax2c, volatile LAS int* tstop_s, float* part, unsigned* flag, int tid, int wid, int lane) {
    const int r32 = lane & 31, hi = lane >> 5, qs = wid >> 1, m = wid & 1;
    const int q0 = qb * 128 + qs * 32, NT = 2 * qb + 2, tdg = 2 * qb + (qs >> 1);
    const int ttop = (type == 1) ? NT / 2 - 1 : NT - 1, tbot = (type == 2) ? NT / 2 : 0;
    const float sl2 = __builtin_amdgcn_exp2f(-(float)(h + 1)) * LOG2E;
#pragma unroll
    for (int i = 0; i < 4; ++i) { const int p = tid + 512 * i, row = p >> 4, ch = p & 15;
        *(LAS u32x4*)(lds + ATT_QOFF + ch * ATT_QCH + row * 16) = *(const u32x4*)(Q + (size_t)(qb * 128 + row) * AW + h * 128 + ch * 8); }
    const int qoff = ATT_QOFF + (m * 8 + hi) * ATT_QCH + (qs * 32 + r32) * 16;
    __syncthreads();
    float qkb;
    { float q2 = 0.f;
#pragma unroll
      for (int d0 = 0; d0 < 4; ++d0)
          { const bf16x8 qf = *(const LAS bf16x8*)(lds + qoff + d0 * 2 * ATT_QCH);
#pragma unroll
            for (int j = 0; j < 8; ++j) { const float v = __builtin_bit_cast(float, (unsigned)(unsigned short)qf[j] << 16); q2 += v * v; } }
      q2 += __shfl_xor(q2, 32);
      float k2 = 0.f;
#pragma unroll
      for (int c = 0; c < 8; ++c) k2 += __builtin_bit_cast(float, kmax2c[(h * 2 + m) * 8 + c]);
      qkb = __builtin_sqrtf(q2 * k2) * 1.002f + 1e-3f; }
    const int sig = (r32 & 0x13) | ((r32 & 8) >> 1) | ((r32 & 4) << 1);
    const int koff = (m * 8 + hi) * ATT_KCH + sig * 16;
    const int voff = ATT_VOFF + hi * ATT_VCH + r32 * 16;
    const int kr0 = 8 * wid + (lane >> 4), kc = lane & 15, ve0 = 16 * wid + (lane >> 3), vc = lane & 7;
    const int kw0 = kc * ATT_KCH + kr0 * 16, kw1 = kw0 + 4 * 16, vw0 = ATT_VOFF + vc * ATT_VCH + ve0 * 16, vw1 = vw0 + 8 * 16;
    const bf16_t* kg = Kg + (size_t)kr0 * AW + h * 128 + kc * 8;
    const bf16_t* vg = VT + (size_t)(h * 128 + ve0) * SEQ + vc * 8;
    f32x16 o[4];
    float lsum = 0.f, moff = 0.f;
    u32x4 sk0, sk1, sv0, sv1;
#define ATT_LOAD(t_) do { sk0 = *(const u32x4*)(kg + (size_t)(t_) * 64 * AW); sk1 = *(const u32x4*)(kg + (size_t)((t_) * 64 + 4) * AW); \
                          sv0 = *(const u32x4*)(vg + (t_) * 64); sv1 = *(const u32x4*)(vg + (size_t)8 * SEQ + (t_) * 64); } while (0)
#define ATT_STORE(sp_) do { *(LAS u32x4*)((sp_) + kw0) = sk0; *(LAS u32x4*)((sp_) + kw1) = sk1; *(LAS u32x4*)((sp_) + vw0) = sv0; *(LAS u32x4*)((sp_) + vw1) = sv1; } while (0)
#define ATT_RESCALE(f_) do { _Pragma("unroll") for (int eb = 0; eb < 4; ++eb) _Pragma("unroll") for (int r = 0; r < 16; ++r) o[eb][r] *= (f_); } while (0)
#define ATT_EXP_PV() do { float ls = 0.f; \
        _Pragma("unroll") for (int r = 0; r < 16; ++r) { p0[r] = __builtin_amdgcn_exp2f(p0[r]); p1[r] = __builtin_amdgcn_exp2f(p1[r]); ls += p0[r] + p1[r]; } \
        lsum += ls; u32x4 pw[4]; \
        _Pragma("unroll") for (int j = 0; j < 4; ++j) { pw[0][j] = pk2(p0[2 * j], p0[2 * j + 1]); pw[1][j] = pk2(p0[8 + 2 * j], p0[9 + 2 * j]); pw[2][j] = pk2(p1[2 * j], p1[2 * j + 1]); pw[3][j] = pk2(p1[8 + 2 * j], p1[9 + 2 * j]); } \
        _Pragma("unroll") for (int ks = 0; ks < 4; ++ks) { const bf16x8 pa = __builtin_bit_cast(bf16x8, pw[ks]); \
            _Pragma("unroll") for (int eb = 0; eb < 4; ++eb) { const bf16x8 vf = *(const LAS bf16x8*)(st + voff + ks * 2 * ATT_VCH + eb * 512); o[eb] = MFMA32(vf, pa, o[eb]); } } } while (0)
    int nit; float mdiag;
    {
        if (tid == 0) *tstop_s = 0x7fffffff;
        {
          const u32x4 ka0 = *(const u32x4*)(kg + (size_t)(NT - 1) * 64 * AW), ka1 = *(const u32x4*)(kg + (size_t)((NT - 1) * 64 + 4) * AW);
          const u32x4 kb0 = *(const u32x4*)(kg + (size_t)(NT - 2) * 64 * AW), kb1 = *(const u32x4*)(kg + (size_t)((NT - 2) * 64 + 4) * AW);
          *(LAS u32x4*)(lds + kw0) = ka0; *(LAS u32x4*)(lds + kw1) = ka1; *(LAS u32x4*)(lds + ATT_STAGE + kw0) = kb0; *(LAS u32x4*)(lds + ATT_STAGE + kw1) = kb1; }
        __syncthreads();
        LAS unsigned char* st = lds + ((qs < 2) ? ATT_STAGE : 0);
        f32x16 p0, p1;
#pragma unroll
        for (int r = 0; r < 16; ++r) { p0[r] = 0.f; p1[r] = 0.f; }
#pragma unroll
        for (int d0 = 0; d0 < 4; ++d0) {
            const bf16x8 a0 = *(const LAS bf16x8*)(st + koff + d0 * 2 * ATT_KCH), a1 = *(const LAS bf16x8*)(st + koff + d0 * 2 * ATT_KCH + 512);
            const bf16x8 qf = *(const LAS bf16x8*)(lds + qoff + d0 * 2 * ATT_QCH);
            p0 = MFMA32(a0, qf, p0); p1 = MFMA32(a1, qf, p1);
        }
        const float dbase = (float)(q0 + r32 - tdg * 64 - 8 * hi);
        float mx = -3e38f;
#pragma unroll
        for (int r = 0; r < 16; ++r) { const float c = (float)(16 * (r >> 3) + (r & 7));
            mx = __builtin_fmaxf(mx, __builtin_fmaxf(__builtin_fmaf(-sl2, __builtin_fabsf(dbase - c), p0[r]), __builtin_fmaf(-sl2, __builtin_fabsf(dbase - (c + 32.f)), p1[r]))); }
        mx = __builtin_fmaxf(mx, __shfl_xor(mx, 32));
        mdiag = mx;
        float b = qkb - mx;
#pragma unroll
        for (int x = 1; x < 32; x <<= 1) b = __builtin_fmaxf(b, __shfl_xor(b, x));
        const float ts = ((float)(q0 - 63) - (b + 136.f) / sl2) * (1.f / 64.f);
        int tsi = (ts > 0.f) ? (int)__builtin_ceilf(ts) : 0; if (!(ts == ts)) tsi = 0;
        if (lane == 0) __hip_atomic_fetch_min((LAS int*)tstop_s, tsi, __ATOMIC_RELAXED, __HIP_MEMORY_SCOPE_WORKGROUP);
        __syncthreads();
        const int tsw = *tstop_s, tlast = tsw > tbot ? tsw : tbot; nit = ttop - tlast + 1; if (nit < 0) nit = 0;
        __syncthreads();
    }
    if (wid >= 4) __builtin_amdgcn_s_setprio(1);
    for (;;) {
#pragma unroll
    for (int eb = 0; eb < 4; ++eb)
#pragma unroll
        for (int r = 0; r < 16; ++r) o[eb][r] = 0.f;
    lsum = 0.f;
    const float mref = mdiag + moff;
    if (nit > 0) { ATT_LOAD(ttop); ATT_STORE(lds); }
    __syncthreads();
    for (int it = 0; it < nit; ++it) {
        const int t = ttop - it; LAS unsigned char* st = lds + (it & 1) * ATT_STAGE;
        const bool more = (it + 1 < nit);
        if (more) ATT_LOAD(t - 1);
        if (t <= tdg) {
            const bool diag = (t == tdg);
            const float dbase = (float)(q0 + r32 - t * 64 - 8 * hi);
            const float A = diag ? -mref : (-sl2 * dbase - mref), sl = diag ? 0.f : sl2;
            f32x16 p0, p1;
#pragma unroll
            for (int r = 0; r < 16; ++r) { const float c = (float)(16 * (r >> 3) + (r & 7)); p0[r] = __builtin_fmaf(sl, c, A); p1[r] = __builtin_fmaf(sl, c + 32.f, A); }
#pragma unroll
            for (int d0 = 0; d0 < 4; ++d0) {
                const bf16x8 a0 = *(const LAS bf16x8*)(st + koff + d0 * 2 * ATT_KCH), a1 = *(const LAS bf16x8*)(st + koff + d0 * 2 * ATT_KCH + 512);
                const bf16x8 qf = *(const LAS bf16x8*)(lds + qoff + d0 * 2 * ATT_QCH);
                p0 = MFMA32(a0, qf, p0); p1 = MFMA32(a1, qf, p1);
            }
            if (diag) {
#pragma unroll
                for (int r = 0; r < 16; ++r) { const float c = (float)(16 * (r >> 3) + (r & 7));
                    p0[r] = __builtin_fmaf(-sl2, __builtin_fabsf(dbase - c), p0[r]); p1[r] = __builtin_fmaf(-sl2, __builtin_fabsf(dbase - (c + 32.f)), p1[r]); }
            }
            ATT_EXP_PV();
        }
        if (more) ATT_STORE(lds + ((it + 1) & 1) * ATT_STAGE);
        __syncthreads();
    }
    lsum += __shfl_xor(lsum, 32);
    const bool bad = !(lsum <= 1.1529215e18f);
    if (!__syncthreads_or(bad ? 1 : 0)) break;
    if (bad) moff += 60.f;
    }
    __builtin_amdgcn_s_setprio(0);
#undef ATT_LOAD
#undef ATT_STORE
#undef ATT_EXP_PV
    if (type == 1) {
        float* pp = part + (size_t)wid * 4096 + lane;
#pragma unroll
        for (int eb = 0; eb < 4; ++eb)
#pragma unroll
            for (int r = 0; r < 16; ++r) pp[(eb * 16 + r) * 64] = o[eb][r];
        part[32768 + wid * 64 + lane] = lsum; part[32768 + 512 + wid * 64 + lane] = moff;
        asm volatile("s_waitcnt vmcnt(0)" ::: "memory");
        __syncthreads();
        if (tid == 0) { __builtin_amdgcn_fence(__ATOMIC_RELEASE, "agent"); asm volatile("s_waitcnt vmcnt(0)" ::: "memory");
                        __hip_atomic_store(flag, 1u, __ATOMIC_RELAXED, __HIP_MEMORY_SCOPE_AGENT); }
        __syncthreads();
    } else {
    if (type == 2) {
        if (tid == 0) { unsigned sp = 0;
            while (__hip_atomic_load(flag, __ATOMIC_RELAXED, __HIP_MEMORY_SCOPE_AGENT) == 0u) { __builtin_amdgcn_s_sleep(8); if (++sp > (1u << 22)) break; }
            __builtin_amdgcn_fence(__ATOMIC_ACQUIRE, "agent"); asm volatile("s_waitcnt vmcnt(0)" ::: "memory"); }
        __syncthreads();
        const float lf = part[32768 + wid * 64 + lane], mf = part[32768 + 512 + wid * 64 + lane];
        const float R = __builtin_fmaxf(moff, mf), sn = __builtin_amdgcn_exp2f(moff - R), sf = __builtin_amdgcn_exp2f(mf - R);
        const float* pp = part + (size_t)wid * 4096 + lane;
#pragma unroll
        for (int eb = 0; eb < 4; ++eb)
#pragma unroll
            for (int r = 0; r < 16; ++r) o[eb][r] = o[eb][r] * sn + pp[(eb * 16 + r) * 64] * sf;
        lsum = lsum * sn + lf * sf;
    }
    { float inv = 1.f / lsum; if (m == 1) inv *= lam; ATT_RESCALE(inv); }
    LAS float* ex = (LAS float*)(lds + ATT_EX + qs * 16384);
    if (m == 1) {
#pragma unroll
        for (int eb = 0; eb < 4; ++eb)
#pragma unroll
            for (int r = 0; r < 16; ++r) ex[(eb * 16 + r) * 64 + lane] = o[eb][r];
    }
    __syncthreads();
    if (m == 0) {
        float ss = 0.f;
#pragma unroll
        for (int eb = 0; eb < 4; ++eb)
#pragma unroll
            for (int r = 0; r < 16; ++r) { o[eb][r] -= ex[(eb * 16 + r) * 64 + lane]; ss += o[eb][r] * o[eb][r]; }
        ss += __shfl_xor(ss, 32);
        const float rs = __builtin_amdgcn_rsqf(ss * (1.f / 128.f) + EPS) * 0.8f;
        bf16_t* op = YC + (size_t)(q0 + r32) * DM + CW + h * 128 + 4 * hi;
#pragma unroll
        for (int eb = 0; eb < 4; ++eb)
#pragma unroll
            for (int g4 = 0; g4 < 4; ++g4) { const int e0 = eb * 32 + 8 * g4; const f32x4 gv = *(const f32x4*)(subln_g + e0 + 4 * hi);
                u32x2 w; w.x = pk2(o[eb][4 * g4] * rs * gv.x, o[eb][4 * g4 + 1] * rs * gv.y); w.y = pk2(o[eb][4 * g4 + 2] * rs * gv.z, o[eb][4 * g4 + 3] * rs * gv.w);
                *(u32x2*)(op + e0) = w; }
    }
    __syncthreads();
    }
#undef ATT_RESCALE
}

#define RLX_AGENT __ATOMIC_RELAXED, __HIP_MEMORY_SCOPE_AGENT
#define XB_TMO      128
#define XB_XCNT(j)  (256  + 64 * (j))
#define XB_XSUB(j)  (1280 + 64 * (j))
#define XB_XGEN(j)  (2304 + 64 * (j))
#define XB_TOP      3328
#define XB_TOPGEN   3392
#define XCD_BAR_WORDS 3456
#define XB_SPIN_CAP (1u << 18)

__device__ __forceinline__ unsigned xb_ld(unsigned* p)              { return __hip_atomic_load(p, __ATOMIC_RELAXED, __HIP_MEMORY_SCOPE_AGENT); }
__device__ __forceinline__ unsigned xb_add(unsigned* p, unsigned v) { return __hip_atomic_fetch_add(p, v, __ATOMIC_RELAXED, __HIP_MEMORY_SCOPE_AGENT); }
__device__ __forceinline__ unsigned xb_xcc_id() { return (unsigned)__builtin_amdgcn_s_getreg((3 << 11) | 20) & 0xFu; }
#define XB_SPIN(cond, bar) do { unsigned _sp = 0; while (cond) { __builtin_amdgcn_s_sleep(1); \
    if ((++_sp & 255u) == 0u) { if (xb_ld(&(bar)[XB_TMO])) break; if (_sp > XB_SPIN_CAP) { atomicAdd(&(bar)[XB_TMO], 1u); break; } } } } while (0)

struct XcdBarrier {
    unsigned* bar; unsigned x;
    volatile LAS unsigned* st;
};
__device__ __forceinline__ XcdBarrier xcd_barrier_post(unsigned* bar, volatile LAS unsigned* st) {
    XcdBarrier b; b.bar = bar; b.x = xb_xcc_id(); b.st = st;
    if (threadIdx.x == 0) (void)xb_add(&bar[XB_XCNT(b.x)], 1u);
    return b;
}
__device__ __forceinline__ void xcd_barrier_complete(unsigned* bar, unsigned x, unsigned& nloc, unsigned& nx) {
    const unsigned G = gridDim.x * gridDim.y * gridDim.z;
    unsigned sum, cnt, mine, sp = 0u;
    for (;;) {
        sum = 0u; cnt = 0u; mine = 0u;
#pragma unroll
        for (unsigned j = 0; j < 16; ++j) { const unsigned c = xb_ld(&bar[XB_XCNT(j)]); sum += c; cnt += (c > 0u) ? 1u : 0u; mine = (j == x) ? c : mine; }
        if (sum == G) break;
        __builtin_amdgcn_s_sleep(1);
        if ((++sp & 255u) == 0u) { if (xb_ld(&bar[XB_TMO])) break; if (sp > XB_SPIN_CAP) { atomicAdd(&bar[XB_TMO], 1u); break; } }
    }
    nloc = mine > 0u ? mine : 1u; nx = cnt > 0u ? cnt : 1u;
}

__device__ __forceinline__ void xcd_barrier(const XcdBarrier& b) {
    asm volatile("s_waitcnt vmcnt(0)" ::: "memory");
    __syncthreads();
    if (threadIdx.x == 0) {
        unsigned* bar = b.bar;
        __builtin_amdgcn_s_waitcnt(0);
        unsigned nloc = b.st[0], nx = b.st[1];
        if (nloc == 0u) { xcd_barrier_complete(bar, b.x, nloc, nx); b.st[0] = nloc; b.st[1] = nx; }
        const unsigned old = xb_add(&bar[XB_XSUB(b.x)], 1u);
        const unsigned gen = old / nloc;
        if (old + 1u == (gen + 1u) * nloc) {
            __builtin_amdgcn_fence(__ATOMIC_RELEASE, "agent");
            asm volatile("s_waitcnt vmcnt(0)" ::: "memory");
            const unsigned og = xb_add(&bar[XB_TOP], 1u);
            const unsigned tg = og / nx;
            if (og + 1u == (tg + 1u) * nx) xb_add(&bar[XB_TOPGEN], 1u);
            else XB_SPIN(xb_ld(&bar[XB_TOPGEN]) == tg, bar);
            __builtin_amdgcn_fence(__ATOMIC_ACQUIRE, "agent");
            xb_add(&bar[XB_XGEN(b.x)], 1u);
            asm volatile("s_waitcnt vmcnt(0)" ::: "memory");
        } else {
            XB_SPIN(xb_ld(&bar[XB_XGEN(b.x)]) == gen, bar);
            __builtin_amdgcn_fence(__ATOMIC_ACQUIRE, "agent");
            asm volatile("s_waitcnt vmcnt(0)" ::: "memory");
        }
    }
    __syncthreads();
}
struct Args { const float* in[24]; float* out; unsigned char* ws; int ph_lo, ph_hi; };
enum { I_X = 0, I_C, I_WADA, I_BADA, I_GPRE, I_GPOST, I_W1G, I_W1U, I_W1D, I_WIN, I_BIN, I_WDW, I_BDW, I_LNG, I_LNB, I_LQ1, I_LK1, I_LQ2, I_LK2, I_SUBG, I_WOUT, I_W2G, I_W2U, I_W2D };

__global__ void __launch_bounds__(512) fwd_kernel(Args args) {
    extern __shared__ __attribute__((aligned(16))) unsigned char lds_raw[];
    LAS unsigned char* lds = (LAS unsigned char*)lds_raw;
    cg::grid_group grid = cg::this_grid();
    const int tid = threadIdx.x, lane = tid & 63, wid = __builtin_amdgcn_readfirstlane(tid >> 6);
    const int G = gridDim.x, bx = blockIdx.x;
    const int vcu = (G % 8 == 0) ? (bx % 8) * (G / 8) + bx / 8 : bx;
    const int gw = vcu * 8 + wid, NGW = G * 8;
    unsigned char* ws = args.ws;
    const float* x = args.in[I_X];
    float* modp = (float*)(ws + WS_MODP);
    bf16_t* Wgu1 = (bf16_t*)(ws + WS_WGU1); bf16_t* Wd1 = (bf16_t*)(ws + WS_WD1); bf16_t* Win = (bf16_t*)(ws + WS_WIN); bf16_t* Wout = (bf16_t*)(ws + WS_WOUT);
    bf16_t* Wgu2 = (bf16_t*)(ws + WS_WGU2); bf16_t* Wd2 = (bf16_t*)(ws + WS_WD2);
    bf16_t* Hb = (bf16_t*)(ws + WS_H); bf16_t* ACT = (bf16_t*)(ws + WS_ACT);
    bf16_t* VGb = (bf16_t*)(ws + WS_VG); bf16_t* Qb = (bf16_t*)(ws + WS_Q); bf16_t* Kb = (bf16_t*)(ws + WS_K); bf16_t* VTb = (bf16_t*)(ws + WS_VT); bf16_t* YC = (bf16_t*)(ws + WS_YCAT);
    bf16_t* Yh = (bf16_t*)(ws + WS_Y); float* X1 = (float*)(ws + WS_X1);
    const float* b_ada = args.in[I_BADA]; const float* g_pre = args.in[I_GPRE]; const float* g_post = args.in[I_GPOST];
    const int lo = args.ph_lo, hi_ = args.ph_hi;
    WPtrs WP; WP.w1g = args.in[I_W1G]; WP.w1u = args.in[I_W1U]; WP.w1d = args.in[I_W1D]; WP.win = args.in[I_WIN]; WP.wout = args.in[I_WOUT]; WP.w2g = args.in[I_W2G]; WP.w2u = args.in[I_W2U]; WP.w2d = args.in[I_W2D];
    WP.Wgu1 = Wgu1; WP.Wd1 = Wd1; WP.Win = Win; WP.Wout = Wout; WP.Wgu2 = Wgu2; WP.Wd2 = Wd2;
    volatile LAS unsigned* MISC = (volatile LAS unsigned*)(lds + MISC_OFF);
    if (tid < 16) MISC[tid] = 0u;
    __syncthreads();
    XcdBarrier bar; bar.bar = (unsigned*)ws; bar.x = 0; bar.st = nullptr;
    if (!MK_SPLIT) bar = xcd_barrier_post((unsigned*)ws, MISC);
    if (hi_ > NPHASE + 7) grid.sync();
#ifndef PROBE_DUP
#define PROBE_DUP -1
#endif
#define IN(k) (lo <= (k) && (k) < hi_)
#define SEAM(k) do { if (IN(k) && IN((k) + 1)) xcd_barrier(bar); } while (0)

    if (IN(0)) {
        const float* c = args.in[I_C]; const float* w_ada = args.in[I_WADA];
        for (int it = gw; it < 72 * KSPLIT; it += NGW) {
            const int cc = it % 72, ks = it / 72;
            const float* wp = w_ada + (size_t)(ks * 128) * NMODW + cc * 256 + lane * 4;
            f32x4 a = (f32x4){0.f, 0.f, 0.f, 0.f};
#pragma unroll 8
            for (int k = 0; k < 128; ++k) { const float cv = c[ks * 128 + k]; const float sv = cv * sigm(cv); a += __builtin_nontemporal_load((const f32x4*)(wp + (size_t)k * NMODW)) * sv; }
            *(f32x4*)(modp + (size_t)ks * NMODW + cc * 256 + lane * 4) = a;
        }
        LAS float* scr = (LAS float*)(lds + wid * 16384);
        tr_run<false>(WP, gw, NGW, scr, lane, 0, (G == 256) ? NITEMS_A - I_GU - I_IN / 2 : NITEMS_A);
        __syncthreads();
    }
    SEAM(0);
    if (IN(1)) { float* modfull = (float*)(ws + 3 * MiB);
        for (int i = bx * 512 + tid; i < NMODW / 4; i += G * 512) *(f32x4*)(modfull + 4 * i) = mod4(modp, b_ada, 4 * i); }
    if (IN(1)) row_phase<false, true, false>(lds, gw, NGW, tid, lane, nullptr, x, nullptr, Hb, modp, b_ada, nullptr, 0, 0.f, g_pre, 0, 1);
    SEAM(1);
    if (IN(2)) {
        const int Gg = (G == 256) ? 240 : G;
        if (bx < Gg) { pg8::Gemm g{Hb, Wgu1, SEQ, 2 * DFF, DM}; pg8::StaticOrder S; S.init(SEQ, 2 * DFF, Gg, bx); EpiSwiGLU E{ACT, DFF};
            pg8::gemm_phase<EpiSwiGLU, pg8::StaticOrder, PG8_ALIGN, PG8_SP2>(lds, g, S, E); }
        else { LAS float* scr = (LAS float*)(lds + wid * 16384); tr_run<false>(WP, (bx - Gg) * 8 + wid, (G - Gg) * 8, scr, lane, NITEMS_A - I_GU - I_IN / 2, NITEMS_A); __syncthreads(); }
    }
    SEAM(2);
    if (IN(3)) { pg8::Gemm g{ACT, Wd1, SEQ, DM, DFF}; pg8::StaticOrder S; S.init(SEQ, DM, G, bx); EpiBf16Plain E{Yh, DM};
        pg8::gemm_phase<EpiBf16Plain, pg8::StaticOrder, PG8_ALIGN, PG8_SP2>(lds, g, S, E); }
    SEAM(3);
    if (IN(4)) row_phase<true, true, true, false, true>(lds, gw, NGW, tid, lane, Yh, x, X1, Hb, (const float*)(ws + 3 * MiB), b_ada, g_post, 2, 0.5f, g_pre + DM, 3, 4);
    SEAM(4);
    if (IN(5)) {
        { pg8::Gemm g{Hb, Win, SEQ, 4096, DM}; pg8::StaticOrder S; S.init(SEQ, 4096, G, bx); EpiInProj E{VGb, Qb, Kb, args.in[I_BIN], (unsigned*)(ws + 16384)};
          pg8::gemm_phase<EpiInProj, pg8::StaticOrder, PG8_ALIGN, PG8_SP2>(lds, g, S, E); }
        { pg8::Gemm g{Win + (size_t)4096 * DM, Hb, AW, SEQ, DM}; pg8::StaticOrder S; S.init(AW, SEQ, G, bx); EpiBf16Plain E{VTb, SEQ};
          pg8::gemm_phase<EpiBf16Plain, pg8::StaticOrder, PG8_ALIGN, PG8_SP2>(lds, g, S, E); }
        { constexpr int NU = (AW / 256) * (SEQ / 256); const int nbusy = NU < G ? NU : G;
          LAS float* scr = (LAS float*)(lds + wid * 16384);
          const bool all = (nbusy == G);
          if (all || bx >= nbusy) { tr_run<true>(WP, all ? gw : (bx - nbusy) * 8 + wid, all ? NGW : (G - nbusy) * 8, scr, lane); __syncthreads(); } }
    }
    SEAM(5);
    if (IN(6)) {
        for (int u = vcu; u < SEQ / 32; u += G) conv_unit(lds, 32 * u, VGb, args.in[I_WDW], args.in[I_BDW], args.in[I_LNG], args.in[I_LNB], YC, tid, wid, lane);
        float lam;
        { const float a = wave_sum(args.in[I_LQ1][lane] * args.in[I_LK1][lane]), b = wave_sum(args.in[I_LQ2][lane] * args.in[I_LK2][lane]);
          lam = __expf(a) - __expf(b) + 0.2f; }
#pragma unroll 1
        for (int wg = bx; wg < 256; wg += G)
#pragma unroll 1
            for (int k = 0; k < SCHED_W; ++k) { const unsigned code = SCHED[wg][k]; if (code == 0xFFFFu) break;
                const int type = (int)(code >> 9), h = (int)((code >> 6) & 7), qb = (int)(code & 63);
                int slot = (h - SPLIT_H0) * SPLIT_NQ + (qb - SPLIT_QB0); if (type == 0 || slot < 0 || slot >= SCHED_NSLOT) slot = 0;
                attn_unit(lds, type, h, qb, Qb, Kb, VTb, YC, args.in[I_SUBG], lam, (const unsigned*)(ws + 16384), (volatile LAS int*)(MISC + 12),
                          (float*)(ws + WS_PART) + (size_t)slot * PART_FLOATS, (unsigned*)(ws + 20480) + slot, tid, wid, lane); }
    }
    SEAM(6);
    if (IN(7)) { pg8::Gemm g{YC, Wout, SEQ, DM, DM}; pg8::StaticOrder S; S.init(SEQ, DM, G, bx); EpiBf16Plain E{Yh, DM};
        pg8::gemm_phase<EpiBf16Plain, pg8::StaticOrder, PG8_ALIGN, PG8_SP2>(lds, g, S, E); }
    SEAM(7);
    if (IN(8)) row_phase<true, true, true, true, true>(lds, gw, NGW, tid, lane, Yh, X1, X1, Hb, (const float*)(ws + 3 * MiB), b_ada, g_post + DM, 5, 1.f, g_pre + 2 * DM, 6, 7);
    SEAM(8);
    if (IN(9)) { pg8::Gemm g{Hb, Wgu2, SEQ, 2 * DFF, DM}; pg8::StaticOrder S; S.init(SEQ, 2 * DFF, G, bx); EpiSwiGLU E{ACT, DFF};
        pg8::gemm_phase<EpiSwiGLU, pg8::StaticOrder, PG8_ALIGN, PG8_SP2>(lds, g, S, E); }
    SEAM(9);
    if (IN(10)) { pg8::Gemm g{ACT, Wd2, SEQ, DM, DFF}; pg8::StaticOrder S; S.init(SEQ, DM, G, bx); EpiBf16Plain E{Yh, DM};
        pg8::gemm_phase<EpiBf16Plain, pg8::StaticOrder, PG8_ALIGN, PG8_SP2>(lds, g, S, E); }
    SEAM(10);
    if (IN(11)) row_phase<true, false, true, true, false>(lds, gw, NGW, tid, lane, Yh, X1, args.out, nullptr, (const float*)(ws + 3 * MiB), b_ada, g_post + 2 * DM, 8, 0.5f, nullptr, 0, 0);
#undef IN
#undef SEAM
}

extern "C" void kernel_launch(void* const* d_in, const int* in_sizes, int n_in, void* d_out, int out_size, void* d_ws, size_t ws_size, hipStream_t stream) {
    static int grid = 0;
    if (grid == 0) {
        if (n_in != 24 || in_sizes[0] != SEQ * DM || out_size != SEQ * DM || ws_size < WS_END) { fprintf(stderr, "kernel_launch: unexpected shapes / workspace (n_in %d, ws %zu)\n", n_in, ws_size); grid = -1; return; }
        int dev = 0, cus = 0, per_cu = 0;
        if (hipGetDevice(&dev) != hipSuccess || hipDeviceGetAttribute(&cus, hipDeviceAttributeMultiprocessorCount, dev) != hipSuccess) { grid = -1; return; }
        if (hipFuncSetAttribute((const void*)fwd_kernel, hipFuncAttributeMaxDynamicSharedMemorySize, LDS_BYTES) != hipSuccess) { fprintf(stderr, "kernel_launch: hipFuncSetAttribute failed\n"); grid = -1; return; }
        if (hipOccupancyMaxActiveBlocksPerMultiprocessor(&per_cu, (const void*)fwd_kernel, 512, LDS_BYTES) != hipSuccess || per_cu < 1) { fprintf(stderr, "kernel_launch: occupancy query says %d\n", per_cu); per_cu = 1; }
        (void)hipGetLastError();
        grid = cus * 1;
        if (grid > 256) grid = 256;
    }
    if (grid < 0) return;
    if (hipMemsetAsync(d_ws, 0, 32768, stream) != hipSuccess) { fprintf(stderr, "kernel_launch: memset failed\n"); return; }
    Args a{};
    for (int i = 0; i < 24; ++i) a.in[i] = (const float*)d_in[i];
    a.out = (float*)d_out; a.ws = (unsigned char*)d_ws;
#if MK_SPLIT
    for (int p = 0; p < NPHASE; ++p) { a.ph_lo = p; a.ph_hi = p + 1; for (int r = 0; r < (p == PROBE_DUP ? 2 : 1); ++r) hipLaunchKernelGGL(fwd_kernel, dim3(grid), dim3(512), LDS_BYTES, stream, a); }
#else
    a.ph_lo = 0; a.ph_hi = NPHASE;
    void* kargs[] = {&a};
    hipError_t e = hipLaunchCooperativeKernel((const void*)fwd_kernel, dim3(grid), dim3(512), kargs, LDS_BYTES, stream);
    if (e != hipSuccess) fprintf(stderr, "kernel_launch: cooperative launch failed: %s (grid %d)\n", hipGetErrorString(e), grid);
#endif
}
```
